# Optimizing an MI355X kernel written in HIP

```python
import math
import jax, jax.numpy as jnp
from jax import lax
import numpy as np

D_MODEL = 2048
BATCH = 16
SEQ = 2048
DEPTH = 1

MEM_LEN = 256
D_FF = 5632
POOL_GROUPS = 4
POOL_GROUP_DIM = 128
POOL_WIDTH = POOL_GROUPS * POOL_GROUP_DIM
POOL_WINDOWS = (2, 4, 8, 16)
FOX_HEADS = 16
FOX_HEAD_DIM = 64
FOX_WIDTH = FOX_HEADS * FOX_HEAD_DIM
MEM_HEADS = 4
MEM_HEAD_DIM = 128
MEM_WIDTH = MEM_HEADS * MEM_HEAD_DIM
N_BRANCHES = 3
GATE_WIDTH = N_BRANCHES * D_MODEL
Q_BLOCK = 128
EPS = 1e-6
IN_SPLITS = (POOL_WIDTH, FOX_WIDTH, FOX_WIDTH, FOX_WIDTH, FOX_HEADS, MEM_WIDTH, GATE_WIDTH)
IN_WIDTH = sum(IN_SPLITS)

kernel_name = "hybrid_pool_fox_memxattn_macaron"


def rmsnorm(x, g):
    xf = x.astype(jnp.float32)
    y = xf * lax.rsqrt(jnp.mean(xf * xf, axis=-1, keepdims=True) + EPS)
    return (y * g.astype(jnp.float32)).astype(x.dtype)


def swiglu_half_ffn(x, norm_g, w_gate_up, w_down):
    h = rmsnorm(x, norm_g)
    gate, up = jnp.split(h @ w_gate_up, 2, axis=-1)
    return 0.5 * ((jax.nn.silu(gate) * up) @ w_down)


def causal_window_mean(u, w):
    S = u.shape[1]
    cs = jnp.cumsum(u.astype(jnp.float32), axis=1)
    lagged = jnp.pad(cs, ((0, 0), (w, 0), (0, 0)))[:, :S]
    count = jnp.minimum(jnp.arange(1, S + 1), w).astype(jnp.float32)
    return ((cs - lagged) / count[None, :, None]).astype(u.dtype)


def pool_mixer(u, pool_w, pool_scale):
    B, S, _ = u.shape
    groups = u.reshape(B, S, POOL_GROUPS, POOL_GROUP_DIM)
    pooled = jnp.stack([causal_window_mean(groups[:, :, g], POOL_WINDOWS[g])
                        for g in range(POOL_GROUPS)], axis=2)
    mixed = jnp.einsum('bsgc,gcd->bsgd', pooled - groups, pool_w)
    return mixed.reshape(B, S, POOL_WIDTH) * pool_scale


def forgetting_attention(q, k, v, log_f):
    B, S, H, Dh = q.shape
    c = jnp.cumsum(log_f, axis=1).transpose(0, 2, 1)
    scale = Dh ** -0.5
    outs = []
    for i in range(S // Q_BLOCK):
        q0, q1 = i * Q_BLOCK, (i + 1) * Q_BLOCK
        logits = jnp.einsum('bqhd,bkhd->bhqk', q[:, q0:q1], k[:, :q1]).astype(jnp.float32) * scale
        logits = logits + c[:, :, q0:q1, None] - c[:, :, None, :q1]
        causal = (q0 + jnp.arange(Q_BLOCK))[:, None] >= jnp.arange(q1)[None, :]
        logits = jnp.where(causal[None, None], logits, -jnp.inf)
        p = jax.nn.softmax(logits, axis=-1).astype(v.dtype)
        outs.append(jnp.einsum('bhqk,bkhd->bqhd', p, v[:, :q1]))
    return jnp.concatenate(outs, axis=1)


def memory_attention(q, k, v):
    scale = q.shape[-1] ** -0.5
    logits = jnp.einsum('bshd,bmhd->bhsm', q, k).astype(jnp.float32) * scale
    p = jax.nn.softmax(logits, axis=-1).astype(v.dtype)
    return jnp.einsum('bhsm,bmhd->bshd', p, v)


def setup_inputs(seed: int = 0) -> dict:
    key = jax.random.key(seed)
    ks = jax.random.split(key, 24)
    nrm = lambda k, shape, fan_in: jax.random.normal(k, shape, jnp.float32) * fan_in ** -0.5
    gain = lambda k, shape: 1.0 + 0.1 * jax.random.normal(k, shape, jnp.float32)
    L = DEPTH
    return {
        "x": jax.random.normal(ks[0], (BATCH, SEQ, D_MODEL), jnp.float32),
        "mem": jax.random.normal(ks[1], (BATCH, MEM_LEN, D_MODEL), jnp.float32),
        "ffn1_norm": gain(ks[2], (L, D_MODEL)),
        "ffn1_w_gate_up": nrm(ks[3], (L, D_MODEL, 2 * D_FF), D_MODEL),
        "ffn1_w_down": nrm(ks[4], (L, D_FF, D_MODEL), D_FF),
        "mix_norm": gain(ks[5], (L, D_MODEL)),
        "mem_norm": gain(ks[6], (L, D_MODEL)),
        "w_in": nrm(ks[7], (L, D_MODEL, IN_WIDTH), D_MODEL),
        "b_forget": 2.0 + 0.1 * jax.random.normal(ks[8], (L, FOX_HEADS), jnp.float32),
        "pool_w": nrm(ks[9], (L, POOL_GROUPS, POOL_GROUP_DIM, POOL_GROUP_DIM), POOL_GROUP_DIM),
        "pool_scale": gain(ks[10], (L, POOL_WIDTH)),
        "w_pool_up": nrm(ks[11], (L, POOL_WIDTH, D_MODEL), POOL_WIDTH),
        "fox_q_norm": gain(ks[12], (L, FOX_HEAD_DIM)),
        "fox_k_norm": gain(ks[13], (L, FOX_HEAD_DIM)),
        "w_fox_o": nrm(ks[14], (L, FOX_WIDTH, D_MODEL), FOX_WIDTH),
        "w_mem_kv": nrm(ks[15], (L, D_MODEL, 2 * MEM_WIDTH), D_MODEL),
        "mem_q_norm": gain(ks[16], (L, MEM_HEAD_DIM)),
        "mem_k_norm": gain(ks[17], (L, MEM_HEAD_DIM)),
        "w_mem_o": nrm(ks[18], (L, MEM_WIDTH, D_MODEL), MEM_WIDTH),
        "w_out": nrm(ks[19], (L, D_MODEL, D_MODEL), D_MODEL),
        "ffn2_norm": gain(ks[20], (L, D_MODEL)),
        "ffn2_w_gate_up": nrm(ks[21], (L, D_MODEL, 2 * D_FF), D_MODEL),
        "ffn2_w_down": nrm(ks[22], (L, D_FF, D_MODEL), D_FF),
    }


def reference(x, mem, ffn1_norm, ffn1_w_gate_up, ffn1_w_down, mix_norm, mem_norm, w_in,
              b_forget, pool_w, pool_scale, w_pool_up, fox_q_norm, fox_k_norm, w_fox_o,
              w_mem_kv, mem_q_norm, mem_k_norm, w_mem_o, w_out,
              ffn2_norm, ffn2_w_gate_up, ffn2_w_down):
    B, S, _ = x.shape
    M = mem.shape[1]
    split_idx = list(np.cumsum(IN_SPLITS)[:-1])
    for l in range(DEPTH):
        x = x + swiglu_half_ffn(x, ffn1_norm[l], ffn1_w_gate_up[l], ffn1_w_down[l])

        h = rmsnorm(x, mix_norm[l])
        u_pool, q_f, k_f, v_f, f_logit, q_m, gate_logit = jnp.split(h @ w_in[l], split_idx, axis=-1)

        y_pool = pool_mixer(u_pool, pool_w[l], pool_scale[l]) @ w_pool_up[l]

        q_f = rmsnorm(q_f.reshape(B, S, FOX_HEADS, FOX_HEAD_DIM), fox_q_norm[l])
        k_f = rmsnorm(k_f.reshape(B, S, FOX_HEADS, FOX_HEAD_DIM), fox_k_norm[l])
        v_f = v_f.reshape(B, S, FOX_HEADS, FOX_HEAD_DIM)
        log_f = jax.nn.log_sigmoid(f_logit.astype(jnp.float32) + b_forget[l].astype(jnp.float32))
        y_fox = forgetting_attention(q_f, k_f, v_f, log_f).reshape(B, S, FOX_WIDTH) @ w_fox_o[l]

        k_m, v_m = jnp.split(rmsnorm(mem, mem_norm[l]) @ w_mem_kv[l], 2, axis=-1)
        q_m = rmsnorm(q_m.reshape(B, S, MEM_HEADS, MEM_HEAD_DIM), mem_q_norm[l])
        k_m = rmsnorm(k_m.reshape(B, M, MEM_HEADS, MEM_HEAD_DIM), mem_k_norm[l])
        v_m = v_m.reshape(B, M, MEM_HEADS, MEM_HEAD_DIM)
        y_mem = memory_attention(q_m, k_m, v_m).reshape(B, S, MEM_WIDTH) @ w_mem_o[l]

        g_pool, g_fox, g_mem = jnp.split(jax.nn.sigmoid(gate_logit), N_BRANCHES, axis=-1)
        merged = g_pool * y_pool + g_fox * y_fox + g_mem * y_mem
        x = x + merged @ w_out[l]

        x = x + swiglu_half_ffn(x, ffn2_norm[l], ffn2_w_gate_up[l], ffn2_w_down[l])
    return x
```

```cpp
#define MK_N_LAUNCHES 1
#include <hip/hip_runtime.h>
#include <hip/hip_cooperative_groups.h>
namespace cg = cooperative_groups;
#include <hip/hip_runtime.h>
#include <cstdio>
#include <cstdint>
namespace pg8 {
#define PG8_LAS __attribute__((address_space(3)))
typedef unsigned short bf16_t;
typedef short bf16x8 __attribute__((ext_vector_type(8)));
typedef float f32x4 __attribute__((ext_vector_type(4)));
typedef unsigned u32x4 __attribute__((ext_vector_type(4)));
constexpr int BM = 256, BK = 64, HALF = 128, HTB = HALF * BK * 2  , STAGE_BYTES = 8 * HTB, NXCD = 8, WGM = 8;

__host__ __device__ __forceinline__ int lds_byte(int r, int c) { const int st = (r >> 4) * 2 + (c >> 5), rr = r & 15, cc = c & 31, ob = rr * 64 + cc * 2; return st * 1024 + (ob ^ (((ob >> 9) & 1) << 5)); }
__host__ __device__ __forceinline__ void stage_rc(int b, int& R, int& C) { const int st = b / 1024, sb = b % 1024, swz = sb ^ (((sb >> 9) & 1) << 5); R = (st >> 1) * 16 + swz / 64; C = (st & 1) * 32 + (swz % 64) / 2; }
__host__ __device__ __forceinline__ int perm32(int rho) { const int n = rho >> 4, i = rho & 15; return 8 * (i >> 2) + 4 * n + (i & 3); }

struct Unit { int pm, pn; };
struct Gemm { const bf16_t* A; const bf16_t* Bt; int M, N, K; };

struct StaticOrder {
    int nM, nN, nwg, G, c;
    __host__ __device__ void init(int M, int N, int G_, int c_) { nM = M / BM; nN = N / BM; nwg = nM * nN; G = G_; c = c_; }
    __host__ __device__ bool next(int i, Unit& u) const {
        const long L = (long)i * G + c; if (L >= nwg) return false;
        int wgid = (int)L; { const int q = nwg / NXCD, r = nwg % NXCD, xcd = wgid % NXCD, off = wgid / NXCD; wgid = (xcd < r ? xcd * (q + 1) : r * (q + 1) + (xcd - r) * q) + off; }
        const int nig = WGM * nN, gid = wgid / nig, fm = gid * WGM, gsz = (nM - fm) < WGM ? (nM - fm) : WGM;
        u.pm = fm + ((wgid % nig) % gsz); u.pn = (wgid % nig) / gsz; return true;
    }
    __device__ __forceinline__ void a_ready(const Unit&) const {}
    __device__ __forceinline__ void done(const Unit&) const {}
};

__device__ __forceinline__ unsigned cvt_pk_bf16(float lo, float hi) { unsigned r; asm volatile("v_cvt_pk_bf16_f32 %0, %1, %2" : "=v"(r) : "v"(lo), "v"(hi)); return r; }
typedef float f32x2 __attribute__((ext_vector_type(2)));
__device__ __forceinline__ f32x2 gelu_pk(f32x2 v) {
    const f32x2 av = __builtin_elementwise_abs(v), d = av * 0.2316418882f + 1.0f;
    f32x2 t; t.x = __builtin_amdgcn_rcpf(d.x); t.y = __builtin_amdgcn_rcpf(d.y);
    f32x2 q = t * 0.5307027145f + (-0.7265760135f); q = q * t + 0.7107068705f; q = q * t + (-0.142248368f); q = q * t + 0.127414796f; q = q * t;
    const f32x2 s = (v * v) * (-0.72134752044f);
    f32x2 e; e.x = __builtin_amdgcn_exp2f(s.x); e.y = __builtin_amdgcn_exp2f(s.y);
    const f32x2 m = v * (q * e), r = v - m;
    f32x2 o; o.x = v.x < 0.f ? m.x : r.x; o.y = v.y < 0.f ? m.y : r.y; return o;
}

template <int ACT  > struct EpiBf16 {
    static constexpr bool PERM = true, AFTER_DRAIN = false, HOOK = false; static constexpr int H1 = -1, H2 = -1; static_assert(ACT == 0 || ACT == 1, "EpiBf16: ACT is 0 (none) or 1 (gelu_pk)");
    bf16_t* O; int ldc; const float* bias; int split_cols; size_t split_stride; float scale0;
    __device__ __forceinline__ void operator()(const f32x4 (&acc)[2][2][4][2], const Unit& u, int wr, int wc, int fr, int fq) const {
        const int row0 = u.pm * BM + wr * 64 + fr; int colt = u.pn * BM; bf16_t* base = O;
        float sc = 1.f; if (split_cols) { const int t = colt / split_cols; base += (size_t)t * split_stride; colt -= t * split_cols; if (t == 0) sc = scale0; }
        const int col0 = colt + wc * 32 + 8 * fq, bcol0 = u.pn * BM + wc * 32 + 8 * fq;
        f32x4 bv[2][2];
#pragma unroll
        for (int bj = 0; bj < 2; ++bj)
#pragma unroll
            for (int n = 0; n < 2; ++n) bv[bj][n] = bias ? *(const f32x4*)(bias + bcol0 + bj * HALF + 4 * n) : (f32x4){0.f, 0.f, 0.f, 0.f};
#pragma unroll
        for (int ai = 0; ai < 2; ++ai)
#pragma unroll
            for (int m = 0; m < 4; ++m) { bf16_t* rowp = base + (size_t)(row0 + ai * HALF + m * 16) * ldc + col0;
#pragma unroll
                for (int bj = 0; bj < 2; ++bj) { f32x4 v0 = acc[ai][bj][m][0] + bv[bj][0], v1 = acc[ai][bj][m][1] + bv[bj][1];
                    if (ACT == 1) { f32x2 a = gelu_pk((f32x2){v0[0], v0[1]}), b = gelu_pk((f32x2){v0[2], v0[3]}), c = gelu_pk((f32x2){v1[0], v1[1]}), d = gelu_pk((f32x2){v1[2], v1[3]});
                        v0 = (f32x4){a.x, a.y, b.x, b.y}; v1 = (f32x4){c.x, c.y, d.x, d.y}; }
                    v0 = v0 * sc; v1 = v1 * sc; u32x4 w; w.x = cvt_pk_bf16(v0[0], v0[1]); w.y = cvt_pk_bf16(v0[2], v0[3]); w.z = cvt_pk_bf16(v1[0], v1[1]); w.w = cvt_pk_bf16(v1[2], v1[3]);
                    *(u32x4*)(rowp + bj * HALF) = w; } }
    }
};
__device__ __forceinline__ float sigm_f(float g) { return __builtin_amdgcn_rcpf(1.0f + __builtin_amdgcn_exp2f(-1.4426950408889634f * g)); }
__device__ __forceinline__ float silu_f(float g) { return g * sigm_f(g); }
__device__ __forceinline__ float sigm2_f(float x) { return __builtin_amdgcn_rcpf(1.0f + __builtin_amdgcn_exp2f(-x)); }
__device__ __forceinline__ float gate_f(float x) { return fmaxf(sigm2_f(x), 1e-18f); }
__device__ __forceinline__ float bf_lo(unsigned w) { return __uint_as_float(w << 16); }
__device__ __forceinline__ float bf_hi(unsigned w) { return __uint_as_float(w & 0xffff0000u); }
__device__ __forceinline__ float logsig_f(float x) { return fminf(x, 0.f) - 0.6931471805599453f * __builtin_amdgcn_logf(1.0f + __builtin_amdgcn_exp2f(-1.4426950408889634f * fabsf(x))); }

struct EpiSwiGLU {
    static constexpr bool PERM = true, AFTER_DRAIN = false, HOOK = false; static constexpr int H1 = -1, H2 = -1;
    bf16_t* O; int ldc; const float* ssq;
    __device__ __forceinline__ void operator()(const f32x4 (&acc)[2][2][4][2], const Unit& u, int wr, int wc, int fr, int fq) const {
        const int row0 = u.pm * BM + wr * 64 + fr, col0 = u.pn * HALF + wc * 32 + 8 * fq;
#pragma unroll
        for (int ai = 0; ai < 2; ++ai)
#pragma unroll
            for (int m = 0; m < 4; ++m) { bf16_t* p = O + (size_t)(row0 + ai * HALF + m * 16) * ldc + col0;
                const float rs = ssq ? 1.0f / sqrtf(ssq[row0 + ai * HALF + m * 16] * (1.0f / 2048.0f) + 1e-6f) : 1.0f;
                const f32x4 g0 = acc[ai][0][m][0] * rs, g1 = acc[ai][0][m][1] * rs, u0 = acc[ai][1][m][0] * rs, u1 = acc[ai][1][m][1] * rs;
                u32x4 w; w.x = cvt_pk_bf16(g0[0] * sigm2_f(g0[0]) * u0[0], g0[1] * sigm2_f(g0[1]) * u0[1]); w.y = cvt_pk_bf16(g0[2] * sigm2_f(g0[2]) * u0[2], g0[3] * sigm2_f(g0[3]) * u0[3]);
                w.z = cvt_pk_bf16(g1[0] * sigm2_f(g1[0]) * u1[0], g1[1] * sigm2_f(g1[1]) * u1[1]); w.w = cvt_pk_bf16(g1[2] * sigm2_f(g1[2]) * u1[2], g1[3] * sigm2_f(g1[3]) * u1[3]);
                *(u32x4*)p = w; }
    }
};
struct EpiResid {
    static constexpr bool PERM = true, AFTER_DRAIN = false, HOOK = false; static constexpr int H1 = -1, H2 = -1;
    const float* basef; const bf16_t* baseb; float* outf; bf16_t* outb; float* ssq; int ldc; float alpha;
    __device__ __forceinline__ void operator()(const f32x4 (&acc)[2][2][4][2], const Unit& u, int wr, int wc, int fr, int fq) const {
        const int col0 = u.pn * BM + wc * 32 + 8 * fq;
#pragma unroll
        for (int ai = 0; ai < 2; ++ai) {
            f32x4 bf0[4][2], bf1[4][2]; u32x4 bq[4][2];
#pragma unroll
            for (int m = 0; m < 4; ++m)
#pragma unroll
                for (int bj = 0; bj < 2; ++bj) { const size_t idx = (size_t)(u.pm * BM + ai * HALF + wr * 64 + m * 16 + fr) * ldc + col0 + bj * HALF;
                    if (basef) { bf0[m][bj] = *(const f32x4*)(basef + idx); bf1[m][bj] = *(const f32x4*)(basef + idx + 4); } else bq[m][bj] = *(const u32x4*)(baseb + idx); }
#pragma unroll
            for (int m = 0; m < 4; ++m) { const int row = u.pm * BM + ai * HALF + wr * 64 + m * 16 + fr; const size_t off = (size_t)row * ldc + col0; float ss = 0.f;
#pragma unroll
                for (int bj = 0; bj < 2; ++bj) { const size_t idx = off + bj * HALF; f32x4 b0, b1;
                    if (basef) { b0 = bf0[m][bj]; b1 = bf1[m][bj]; }
                    else { const u32x4 q = bq[m][bj]; b0 = (f32x4){bf_lo(q.x), bf_hi(q.x), bf_lo(q.y), bf_hi(q.y)}; b1 = (f32x4){bf_lo(q.z), bf_hi(q.z), bf_lo(q.w), bf_hi(q.w)}; }
                    const f32x4 v0 = b0 + acc[ai][bj][m][0] * alpha, v1 = b1 + acc[ai][bj][m][1] * alpha;
                    if (outf) { *(f32x4*)(outf + idx) = v0; *(f32x4*)(outf + idx + 4) = v1; }
                    if (outb) { u32x4 w; w.x = cvt_pk_bf16(v0[0], v0[1]); w.y = cvt_pk_bf16(v0[2], v0[3]); w.z = cvt_pk_bf16(v1[0], v1[1]); w.w = cvt_pk_bf16(v1[2], v1[3]); *(u32x4*)(outb + idx) = w; }
                    ss += ((v0[0] * v0[0] + v0[1] * v0[1]) + (v0[2] * v0[2] + v0[3] * v0[3])) + ((v1[0] * v1[0] + v1[1] * v1[1]) + (v1[2] * v1[2] + v1[3] * v1[3])); }
                if (ssq) { ss += __shfl_xor(ss, 16); ss += __shfl_xor(ss, 32); if (fq == 0) (void)__hip_atomic_fetch_add(ssq + row, ss, __ATOMIC_RELAXED, __HIP_MEMORY_SCOPE_AGENT); } } }
    }
};
struct EpiWin {
    static constexpr bool PERM = true, AFTER_DRAIN = false, HOOK = false; static constexpr int H1 = -1, H2 = -1;
    bf16_t *UP, *QF, *KF, *VF, *QM, *GATE; float* LOGF; const float* bfg; const float* ssq; const float *gq, *gk, *gm; PG8_LAS float* X;
    __device__ __forceinline__ void operator()(const f32x4 (&acc)[2][2][4][2], const Unit& u, int wr, int wc, int fr, int fq) const {
        const int pn = u.pn, row0 = u.pm * BM + wr * 64 + fr;
        if (pn == 40) {
            if (wc == 0 && fq < 2) {
                const f32x4 b0 = *(const f32x4*)(bfg + 8 * fq), b1 = *(const f32x4*)(bfg + 8 * fq + 4);
#pragma unroll
                for (int ai = 0; ai < 2; ++ai)
#pragma unroll
                    for (int m = 0; m < 4; ++m) { float* p = LOGF + (size_t)(row0 + ai * HALF + m * 16) * 16 + 8 * fq;
                        const float rs = 1.0f / sqrtf(ssq[row0 + ai * HALF + m * 16] * (1.0f / 2048.0f) + 1e-6f);
                        const f32x4 v0 = acc[ai][0][m][0] * rs + b0, v1 = acc[ai][0][m][1] * rs + b1;
                        *(f32x4*)p = (f32x4){logsig_f(v0[0]), logsig_f(v0[1]), logsig_f(v0[2]), logsig_f(v0[3])};
                        *(f32x4*)(p + 4) = (f32x4){logsig_f(v1[0]), logsig_f(v1[1]), logsig_f(v1[2]), logsig_f(v1[3])}; }
            }
            return;
        }
        bf16_t* O; int ldc, colt; bool sg = false; int hn = 0; const float* gain = nullptr; float hscale = 1.f;
        if (pn < 2) { O = UP; ldc = 512; colt = pn * BM; } else if (pn < 6) { O = QF; ldc = 1024; colt = (pn - 2) * BM; hn = 1; gain = gq; hscale = 0.125f * 1.4426950408889634f; }
        else if (pn < 10) { O = KF; ldc = 1024; colt = (pn - 6) * BM; hn = 1; gain = gk; }
        else if (pn < 14) { O = VF; ldc = 1024; colt = (pn - 10) * BM; } else if (pn < 16) { O = QM; ldc = 512; colt = (pn - 14) * BM; hn = 2; gain = gm; hscale = 0.08838834764831845f * 1.4426950408889634f; }
        else { O = GATE; ldc = 6144; colt = (pn - 16) * BM; sg = true; }
        const int col0 = colt + wc * 32 + 8 * fq;
        float rsv[2][4];
#pragma unroll
        for (int ai = 0; ai < 2; ++ai)
#pragma unroll
            for (int m = 0; m < 4; ++m) rsv[ai][m] = 1.0f / sqrtf(ssq[row0 + ai * HALF + m * 16] * (1.0f / 2048.0f) + 1e-6f);
        if (hn) {
#pragma unroll
            for (int ai = 0; ai < 2; ++ai)
#pragma unroll
                for (int m = 0; m < 4; ++m) { const int rowl = ai * HALF + wr * 64 + m * 16 + fr; const float rs = rsv[ai][m];
#pragma unroll
                    for (int bj = 0; bj < 2; ++bj) { const f32x4 v0 = acc[ai][bj][m][0] * rs, v1 = acc[ai][bj][m][1] * rs;
                        float s = (v0[0] * v0[0] + v0[1] * v0[1]) + (v0[2] * v0[2] + v0[3] * v0[3]) + (v1[0] * v1[0] + v1[1] * v1[1]) + (v1[2] * v1[2] + v1[3] * v1[3]);
                        s += __shfl_xor(s, 16); s += __shfl_xor(s, 32);
                        if (fq == 0) X[(rowl * 2 + bj) * 4 + wc] = s; } }
            asm volatile("s_waitcnt lgkmcnt(0)" ::: "memory"); __builtin_amdgcn_s_barrier(); asm volatile("" ::: "memory");
            const int d0 = (hn == 1 ? 32 * (wc & 1) : 32 * wc) + 8 * fq; const f32x4 g0 = *(const f32x4*)(gain + d0), g1 = *(const f32x4*)(gain + d0 + 4);
            const float ihd = hn == 1 ? (1.0f / 64.0f) : (1.0f / 128.0f);
#pragma unroll
            for (int ai = 0; ai < 2; ++ai)
#pragma unroll
                for (int m = 0; m < 4; ++m) { const int rowl = ai * HALF + wr * 64 + m * 16 + fr; bf16_t* rowp = O + (size_t)(row0 + ai * HALF + m * 16) * ldc + col0;
#pragma unroll
                    for (int bj = 0; bj < 2; ++bj) { const f32x4 xs = *(const PG8_LAS f32x4*)(X + (rowl * 2 + bj) * 4);
                        const float tot = hn == 1 ? ((wc & 2) ? xs[2] + xs[3] : xs[0] + xs[1]) : (xs[0] + xs[1]) + (xs[2] + xs[3]);
                        const float r = rsv[ai][m] * hscale / sqrtf(tot * ihd + 1e-6f);
                        const f32x4 v0 = acc[ai][bj][m][0] * r * g0, v1 = acc[ai][bj][m][1] * r * g1;
                        u32x4 w; w.x = cvt_pk_bf16(v0[0], v0[1]); w.y = cvt_pk_bf16(v0[2], v0[3]); w.z = cvt_pk_bf16(v1[0], v1[1]); w.w = cvt_pk_bf16(v1[2], v1[3]);
                        *(u32x4*)(rowp + bj * HALF) = w; } }
            return;
        }
#pragma unroll
        for (int ai = 0; ai < 2; ++ai)
#pragma unroll
            for (int m = 0; m < 4; ++m) { bf16_t* rowp = O + (size_t)(row0 + ai * HALF + m * 16) * ldc + col0; const float rs = rsv[ai][m];
#pragma unroll
                for (int bj = 0; bj < 2; ++bj) { f32x4 v0 = acc[ai][bj][m][0] * rs, v1 = acc[ai][bj][m][1] * rs;
                    if (sg) { v0 = (f32x4){gate_f(v0[0]), gate_f(v0[1]), gate_f(v0[2]), gate_f(v0[3])}; v1 = (f32x4){gate_f(v1[0]), gate_f(v1[1]), gate_f(v1[2]), gate_f(v1[3])}; }
                    u32x4 w; w.x = cvt_pk_bf16(v0[0], v0[1]); w.y = cvt_pk_bf16(v0[2], v0[3]); w.z = cvt_pk_bf16(v1[0], v1[1]); w.w = cvt_pk_bf16(v1[2], v1[3]);
                    *(u32x4*)(rowp + bj * HALF) = w; } }
    }
};
struct EpiGate {
    static constexpr bool PERM = true, AFTER_DRAIN = false, HOOK = true; static constexpr int H1 = 8, H2 = 24;
    bf16_t* MG; const bf16_t* G;
    __device__ __forceinline__ void hook(f32x4 (&acc)[2][2][4][2], const Unit& u, int t, int wr, int wc, int fr, int fq) const {
        asm volatile("" : "+v"(fr), "+v"(fq));
        const int row0 = u.pm * BM + wr * 64 + fr, col0 = u.pn * BM + wc * 32 + 8 * fq, gnum = (t == H1) ? 0 : 2048;
#pragma unroll
        for (int ai = 0; ai < 2; ++ai) {
            u32x4 ga[4][2], gb[4][2];
            asm volatile("" ::: "memory");
#pragma unroll
            for (int m = 0; m < 4; ++m) { const bf16_t* gp = G + (size_t)(row0 + ai * HALF + m * 16) * 6144 + gnum + col0;
#pragma unroll
                for (int bj = 0; bj < 2; ++bj) { ga[m][bj] = *(const u32x4*)(gp + bj * HALF); gb[m][bj] = *(const u32x4*)(gp + 2048 + bj * HALF); } }
#pragma unroll
            for (int m = 0; m < 4; ++m)
#pragma unroll
                for (int bj = 0; bj < 2; ++bj) { const u32x4 a = ga[m][bj], b = gb[m][bj];
                    const f32x4 r0 = (f32x4){bf_lo(a.x) * __builtin_amdgcn_rcpf(bf_lo(b.x)), bf_hi(a.x) * __builtin_amdgcn_rcpf(bf_hi(b.x)), bf_lo(a.y) * __builtin_amdgcn_rcpf(bf_lo(b.y)), bf_hi(a.y) * __builtin_amdgcn_rcpf(bf_hi(b.y))};
                    const f32x4 r1 = (f32x4){bf_lo(a.z) * __builtin_amdgcn_rcpf(bf_lo(b.z)), bf_hi(a.z) * __builtin_amdgcn_rcpf(bf_hi(b.z)), bf_lo(a.w) * __builtin_amdgcn_rcpf(bf_lo(b.w)), bf_hi(a.w) * __builtin_amdgcn_rcpf(bf_hi(b.w))};
                    acc[ai][bj][m][0] *= r0; acc[ai][bj][m][1] *= r1; }
            asm volatile("" ::: "memory"); }
        asm volatile("s_waitcnt vmcnt(0)" ::: "memory");
    }
    __device__ __forceinline__ void operator()(const f32x4 (&acc)[2][2][4][2], const Unit& u, int wr, int wc, int fr, int fq) const {
        const int row0 = u.pm * BM + wr * 64 + fr, col0 = u.pn * BM + wc * 32 + 8 * fq;
#pragma unroll
        for (int ai = 0; ai < 2; ++ai) {
            u32x4 gq[4][2];
#pragma unroll
            for (int m = 0; m < 4; ++m)
#pragma unroll
                for (int bj = 0; bj < 2; ++bj) gq[m][bj] = *(const u32x4*)(G + (size_t)(row0 + ai * HALF + m * 16) * 6144 + 4096 + col0 + bj * HALF);
#pragma unroll
            for (int m = 0; m < 4; ++m) { const size_t row = (size_t)(row0 + ai * HALF + m * 16);
#pragma unroll
                for (int bj = 0; bj < 2; ++bj) { const int col = col0 + bj * HALF; const u32x4 gv = gq[m][bj];
                    const f32x4 a0 = acc[ai][bj][m][0], a1 = acc[ai][bj][m][1];
                    u32x4 w; w.x = cvt_pk_bf16(bf_lo(gv.x) * a0[0], bf_hi(gv.x) * a0[1]); w.y = cvt_pk_bf16(bf_lo(gv.y) * a0[2], bf_hi(gv.y) * a0[3]);
                    w.z = cvt_pk_bf16(bf_lo(gv.z) * a1[0], bf_hi(gv.z) * a1[1]); w.w = cvt_pk_bf16(bf_lo(gv.w) * a1[2], bf_hi(gv.w) * a1[3]);
                    *(u32x4*)(MG + row * 2048 + col) = w; } } }
    }
};
template <class Epi, class Sched, bool ALIGN_EPI = false, bool SP2 = false>
__device__ __forceinline__ void gemm_phase(PG8_LAS unsigned char* lds, const Gemm g, const Sched& S, const Epi& E) {
    const int tid = threadIdx.x, wid = __builtin_amdgcn_readfirstlane(tid >> 6), lane = tid & 63, wr = wid >> 2, wc = wid & 3, fr = lane & 15, fq = lane >> 4;
    const int K = g.K, nt = K / BK;
    unsigned voffA[2], voffB[2];
#pragma unroll
    for (int i = 0; i < 2; ++i) { int R, C; stage_rc(tid * 16 + i * 8192, R, C); const int Rb = Epi::PERM ? ((R & ~31) + perm32(R & 31)) : R;
        voffA[i] = (unsigned)(R * K + C) * 2u; voffB[i] = (unsigned)(Rb * K + C) * 2u; }
    const size_t kstep = (size_t)(BK * 2);
    const size_t hstep = (size_t)HALF * K * 2;
    const size_t tstep = 2 * hstep;
    const unsigned ldsw = (unsigned)wid * 1024u;
    const int aoff = lds_byte(wr * 64 + fr, fq * 8), boff = lds_byte(wc * 32 + fr, fq * 8);
#define PG8_SA(b, h) (((b) * 2 + (h)) * HTB)
#define PG8_SB(b, h) ((4 + (b) * 2 + (h)) * HTB)
#define PG8_STAGE(bufoff, gbase, voff) do { _Pragma("unroll") for (int _i = 0; _i < 2; ++_i) \
        __builtin_amdgcn_global_load_lds((const unsigned*)((const char*)(gbase) + (voff)[_i]), (PG8_LAS unsigned*)(lds + (bufoff) + ldsw + _i * 8192), 16, 0, 0); } while (0)
#define PG8_LDA(dst, b, h) do { _Pragma("unroll") for (int m = 0; m < 4; ++m) _Pragma("unroll") for (int k = 0; k < 2; ++k) dst[m][k] = *(const PG8_LAS bf16x8*)(lds + PG8_SA(b, h) + aoff + m * 2048 + k * 1024); } while (0)
#define PG8_LDB(dst, b, h) do { _Pragma("unroll") for (int n = 0; n < 2; ++n) _Pragma("unroll") for (int k = 0; k < 2; ++k) dst[n][k] = *(const PG8_LAS bf16x8*)(lds + PG8_SB(b, h) + boff + n * 2048 + k * 1024); } while (0)
#define PG8_MMA(ai, bj, At, Bt) do { __builtin_amdgcn_s_setprio(1); _Pragma("unroll") for (int m = 0; m < 4; ++m) _Pragma("unroll") for (int n = 0; n < 2; ++n) _Pragma("unroll") for (int k = 0; k < 2; ++k) \
        acc[ai][bj][m][n] = __builtin_amdgcn_mfma_f32_16x16x32_bf16(Bt[n][k], At[m][k], acc[ai][bj][m][n], 0, 0, 0); __builtin_amdgcn_s_setprio(0); } while (0)
#define PG8_WAIT_V(n) asm volatile("s_waitcnt vmcnt(" #n ")" ::: "memory")
#define PG8_WAIT_L(n) asm volatile("s_waitcnt lgkmcnt(" #n ")" ::: "memory")
#define PG8_BAR __builtin_amdgcn_s_barrier()
#define PG8_SCHED __builtin_amdgcn_sched_barrier(0)
    Unit cur, nxt; int ui = 0;
    if (!S.next(0, cur)) return;
    f32x4 acc[2][2][4][2];
#pragma unroll
    for (int a = 0; a < 2; ++a)
#pragma unroll
        for (int b = 0; b < 2; ++b)
#pragma unroll
            for (int m = 0; m < 4; ++m)
#pragma unroll
                for (int n = 0; n < 2; ++n) acc[a][b][m][n] = (f32x4){0.f, 0.f, 0.f, 0.f};
    bf16x8 At[4][2], B0[2][2], B1[2][2];
    const char* cA = (const char*)g.A + (size_t)cur.pm * tstep; const char* cB = (const char*)g.Bt + (size_t)cur.pn * tstep;
    S.a_ready(cur);
    if constexpr (SP2) {
        PG8_STAGE(PG8_SB(0, 0), cB, voffB); PG8_STAGE(PG8_SB(0, 1), cB + hstep, voffB); PG8_STAGE(PG8_SA(0, 0), cA, voffA); PG8_STAGE(PG8_SA(0, 1), cA + hstep, voffA);
        if (wr == 1) PG8_BAR;
        PG8_WAIT_V(2); PG8_BAR;
        PG8_STAGE(PG8_SB(1, 0), cB + kstep, voffB); PG8_STAGE(PG8_SA(1, 0), cA + kstep, voffA); PG8_STAGE(PG8_SB(1, 1), cB + hstep + kstep, voffB);
        PG8_WAIT_V(6); PG8_BAR;
    } else {
        PG8_STAGE(PG8_SB(0, 0), cB, voffB); PG8_STAGE(PG8_SA(0, 0), cA, voffA); PG8_STAGE(PG8_SB(0, 1), cB + hstep, voffB); PG8_STAGE(PG8_SA(0, 1), cA + hstep, voffA);
        if (wr == 1) PG8_BAR;
        PG8_WAIT_V(4); PG8_BAR;
        PG8_STAGE(PG8_SB(1, 0), cB + kstep, voffB); PG8_STAGE(PG8_SA(1, 0), cA + kstep, voffA); PG8_STAGE(PG8_SB(1, 1), cB + hstep + kstep, voffB);
        PG8_WAIT_V(6); PG8_BAR;
    }
    for (;;) {
        const bool has_next = S.next(ui + 1, nxt);
        const char* nA = has_next ? (const char*)g.A + (size_t)nxt.pm * tstep : cA; const char* nB = has_next ? (const char*)g.Bt + (size_t)nxt.pn * tstep : cB;
        for (int t = 0; t < nt; t += 2) {
            if constexpr (Epi::HOOK) { if (t == Epi::H1 || t == Epi::H2) E.hook(acc, cur, t, wr, wc, fr, fq); }
            const bool last = (t == nt - 2);
            const char* a1 = cA + (size_t)(t + 1) * kstep;
            const char* a2 = last ? nA : cA + (size_t)(t + 2) * kstep; const char* b2 = last ? nB : cB + (size_t)(t + 2) * kstep;
            const char* a3 = a2 + kstep; const char* b3 = b2 + kstep;
            if (last && has_next) S.a_ready(nxt);
            if constexpr (SP2) {
            PG8_LDB(B0, 0, 0); PG8_LDB(B1, 0, 1); PG8_SCHED; PG8_LDA(At, 0, 0); PG8_STAGE(PG8_SA(1, 1), a1 + hstep, voffA);
            PG8_WAIT_V(8); PG8_WAIT_L(0); PG8_BAR; PG8_MMA(0, 0, At, B0); PG8_MMA(0, 1, At, B1); PG8_BAR; PG8_SCHED;
            PG8_LDA(At, 0, 1); PG8_STAGE(PG8_SB(0, 0), b2, voffB); PG8_STAGE(PG8_SB(0, 1), b2 + hstep, voffB); PG8_STAGE(PG8_SA(0, 0), a2, voffA);
            PG8_WAIT_V(8); PG8_WAIT_L(0); PG8_BAR; PG8_MMA(1, 0, At, B0); PG8_MMA(1, 1, At, B1); PG8_BAR; PG8_SCHED;
            PG8_LDB(B0, 1, 0); PG8_LDB(B1, 1, 1); PG8_SCHED; PG8_LDA(At, 1, 0); PG8_STAGE(PG8_SA(0, 1), a2 + hstep, voffA);
            PG8_WAIT_V(8); PG8_WAIT_L(0); PG8_BAR; PG8_MMA(0, 0, At, B0); PG8_MMA(0, 1, At, B1); PG8_BAR; PG8_SCHED;
            PG8_LDA(At, 1, 1); PG8_STAGE(PG8_SB(1, 0), b3, voffB); PG8_STAGE(PG8_SB(1, 1), b3 + hstep, voffB); PG8_STAGE(PG8_SA(1, 0), a3, voffA);
            PG8_WAIT_V(8); PG8_WAIT_L(0); PG8_BAR; PG8_MMA(1, 0, At, B0); PG8_MMA(1, 1, At, B1); PG8_BAR; PG8_SCHED;
            } else {
            PG8_LDB(B0, 0, 0); PG8_SCHED; PG8_LDA(At, 0, 0); PG8_STAGE(PG8_SA(1, 1), a1 + hstep, voffA);
            PG8_WAIT_L(8); PG8_BAR; PG8_WAIT_L(0); PG8_MMA(0, 0, At, B0); PG8_BAR; PG8_SCHED;
            PG8_LDB(B1, 0, 1); PG8_STAGE(PG8_SB(0, 0), b2, voffB);
            PG8_BAR; PG8_WAIT_L(0); PG8_MMA(0, 1, At, B1); PG8_BAR;
            PG8_LDA(At, 0, 1); PG8_STAGE(PG8_SA(0, 0), a2, voffA);
            PG8_BAR; PG8_WAIT_L(0); PG8_MMA(1, 0, At, B0); PG8_BAR; PG8_SCHED;
            PG8_STAGE(PG8_SB(0, 1), b2 + hstep, voffB);
            PG8_WAIT_V(6); PG8_BAR; PG8_MMA(1, 1, At, B1); PG8_BAR;
            PG8_LDB(B0, 1, 0); PG8_SCHED; PG8_LDA(At, 1, 0); PG8_STAGE(PG8_SA(0, 1), a2 + hstep, voffA);
            PG8_WAIT_L(8); PG8_BAR; PG8_WAIT_L(0); PG8_MMA(0, 0, At, B0); PG8_BAR; PG8_SCHED;
            PG8_LDB(B1, 1, 1); PG8_STAGE(PG8_SB(1, 0), b3, voffB);
            PG8_BAR; PG8_WAIT_L(0); PG8_MMA(0, 1, At, B1); PG8_BAR;
            PG8_LDA(At, 1, 1); PG8_STAGE(PG8_SA(1, 0), a3, voffA);
            PG8_BAR; PG8_WAIT_L(0); PG8_MMA(1, 0, At, B0); PG8_BAR; PG8_SCHED;
            PG8_STAGE(PG8_SB(1, 1), b3 + hstep, voffB);
            PG8_WAIT_V(6); PG8_BAR; PG8_MMA(1, 1, At, B1); PG8_BAR;
            }
        }
        if constexpr (ALIGN_EPI) { if (wr == 0) PG8_BAR; }
        if constexpr (!Epi::AFTER_DRAIN) { E(acc, cur, wr, wc, fr, fq); S.done(cur); }
        if (!has_next) break;
#pragma unroll
        for (int a = 0; a < 2; ++a)
#pragma unroll
            for (int b = 0; b < 2; ++b)
#pragma unroll
                for (int m = 0; m < 4; ++m)
#pragma unroll
                    for (int n = 0; n < 2; ++n) acc[a][b][m][n] = (f32x4){0.f, 0.f, 0.f, 0.f};
        cur = nxt; cA = nA; cB = nB; ++ui;
        if constexpr (ALIGN_EPI) { if (wr == 1) PG8_BAR; }
    }
    PG8_WAIT_V(0);
    if constexpr (!ALIGN_EPI) { if (wr == 0) PG8_BAR; }
    PG8_BAR;
    if constexpr (Epi::AFTER_DRAIN) { E.fused(acc, cur, wr, wc, fr, fq, lds, wid, lane); S.done(cur); }
#undef PG8_SA
#undef PG8_SB
#undef PG8_STAGE
#undef PG8_LDA
#undef PG8_LDB
#undef PG8_MMA
#undef PG8_WAIT_V
#undef PG8_WAIT_L
#undef PG8_BAR
#undef PG8_SCHED
}
}
#include <hip/hip_bf16.h>
#include <cmath>
namespace attn_body {
using bf16=__hip_bfloat16;
using bf16x8=__attribute__((ext_vector_type(8)))short;
using s16x4=__attribute__((ext_vector_type(4)))short;
using f32x16=__attribute__((ext_vector_type(16)))float;
using u32x4=__attribute__((ext_vector_type(4)))unsigned;
constexpr int BATCH=16,NHEAD=16,SEQ=2048,D=64,DM=NHEAD*D;
constexpr int NW=8,QBLK=32,QB=QBLK*NW,KVBLK=64,NQB=SEQ/QB;
constexpr int ATTN_PITCH=DM, ATTN_UNIT_ROWS=QB, OPITCH=2048;
__device__ __forceinline__ int crow(int r,int hi){return (r&3)+8*(r>>2)+4*hi;}
#define SBAR() __builtin_amdgcn_sched_barrier(0)
__device__ __forceinline__ void cmask(f32x16&p0,f32x16&p1,int jb,int qrel,int hi){
  const float NEG=-INFINITY; int kb=64*jb+4*hi;
  #pragma unroll
  for(int r=0;r<16;++r){int kv=kb+(r&3)+8*(r>>2); if(kv>qrel)p0[r]=NEG; if(kv+32>qrel)p1[r]=NEG;}
}

constexpr int NSLOT=3, SLOTB=8192;
constexpr int LDS_K=0, LDS_V=NSLOT*SLOTB, LDS_WS=2*NSLOT*SLOTB, LDS_OST=LDS_WS+NW*64*4, LDS_KB=LDS_OST+NW*4096, LDS_BYTES=LDS_KB+SEQ*4;
constexpr float C2=0.125f*1.4426950408889634f;
__device__ __forceinline__ void glds16(const void*gsrc,unsigned lds_dst){unsigned keep;
  asm volatile("s_mov_b32 %0, m0\n\ts_mov_b32 m0, %2\n\ts_nop 0\n\tglobal_load_lds_dwordx4 %1, off\n\ts_mov_b32 m0, %0":"=&s"(keep):"v"(gsrc),"s"(lds_dst):"memory");}
__device__ __forceinline__ float max3f(float a,float b,float c){float r;asm("v_max3_f32 %0, %1, %2, %3":"=v"(r):"v"(a),"v"(b),"v"(c));return r;}
__device__ __forceinline__ float max2f(float a,float b){float r;asm("v_max_f32_e32 %0, %1, %2":"=v"(r):"v"(a),"v"(b));return r;}
__device__ __forceinline__ float fadd_s(float a,float b){float r;asm("v_add_f32_e32 %0, %1, %2":"=v"(r):"v"(a),"v"(b));return r;}
__device__ __forceinline__ float fsub_s(float a,float b){float r;asm("v_sub_f32_e32 %0, %1, %2":"=v"(r):"v"(a),"v"(b));return r;}
typedef float f32x2_t __attribute__((ext_vector_type(2))); typedef __bf16 bf16x2_t __attribute__((ext_vector_type(2)));
__device__ __forceinline__ unsigned cvtpk_s(float lo,float hi){f32x2_t v={lo,hi};bf16x2_t b=__builtin_convertvector(v,bf16x2_t);return __builtin_bit_cast(unsigned,b);}
#define WAIT_BAR(N) asm volatile("s_waitcnt vmcnt(" #N ") lgkmcnt(0)\n\ts_barrier":::"memory")

__device__ __forceinline__ void qkt(f32x16&p0,f32x16&p1,const char*Kslot,const bf16x8*qr,int r32,int hi){
  const char*kb=Kslot+hi*1024+r32*16;
  #pragma unroll
  for(int d0=0;d0<4;++d0){
    const bf16x8 b0=*reinterpret_cast<const bf16x8*>(kb+d0*2048);
    const bf16x8 b1=*reinterpret_cast<const bf16x8*>(kb+d0*2048+512);
    {p0=__builtin_amdgcn_mfma_f32_32x32x16_bf16(b0,qr[d0],p0,0,0,0);p1=__builtin_amdgcn_mfma_f32_32x32x16_bf16(b1,qr[d0],p1,0,0,0);}}
}
typedef __attribute__((address_space(3))) const char* lds_cptr;
typedef short v4i16_t __attribute__((ext_vector_type(4)));
__device__ __forceinline__ void kload8(bf16x8*kf,lds_cptr kp){
  kf[0]=*(const __attribute__((address_space(3))) bf16x8*)(kp);      kf[1]=*(const __attribute__((address_space(3))) bf16x8*)(kp+512);
  kf[2]=*(const __attribute__((address_space(3))) bf16x8*)(kp+2048); kf[3]=*(const __attribute__((address_space(3))) bf16x8*)(kp+2560);
  kf[4]=*(const __attribute__((address_space(3))) bf16x8*)(kp+4096); kf[5]=*(const __attribute__((address_space(3))) bf16x8*)(kp+4608);
  kf[6]=*(const __attribute__((address_space(3))) bf16x8*)(kp+6144); kf[7]=*(const __attribute__((address_space(3))) bf16x8*)(kp+6656);
}
__device__ __forceinline__ void kload2(bf16x8*kf,lds_cptr kp,int j){ kf[2*j]=*(const __attribute__((address_space(3))) bf16x8*)(kp+j*2048); kf[2*j+1]=*(const __attribute__((address_space(3))) bf16x8*)(kp+j*2048+512); }
__device__ __forceinline__ s16x4 vtr(lds_cptr p){ return __builtin_bit_cast(s16x4,__builtin_amdgcn_ds_read_tr16_b64_v4i16((__attribute__((address_space(3))) v4i16_t*)p)); }
__device__ __forceinline__ float rowmax(const f32x16&p0,const f32x16&p1){
  float a=max3f(p0[0],p0[1],p1[0]),b=max3f(p0[2],p0[3],p1[1]);a=max3f(a,p1[2],p1[3]);
  #pragma unroll
  for(int r=4;r<16;r+=4){a=max3f(a,p0[r],p0[r+1]);b=max3f(b,p0[r+2],p0[r+3]);a=max3f(a,p1[r],p1[r+1]);b=max3f(b,p1[r+2],p1[r+3]);}
  const float m=max2f(a,b);
  auto rr=__builtin_amdgcn_permlane32_swap(__float_as_uint(m),__float_as_uint(m),false,false);
  return max2f(__uint_as_float(rr[0]),__uint_as_float(rr[1]));
}
__device__ __forceinline__ void pv(f32x16*o,int vb,bf16x8 pa0,bf16x8 pa1,bf16x8 pa2,bf16x8 pa3){
  #pragma unroll
  for(int d0=0;d0<2;++d0){s16x4 lo[4],hi[4];
    #pragma unroll
    for(int ks=0;ks<4;++ks){
      asm volatile("ds_read_b64_tr_b16 %0,%1 offset:%c2":"=&v"(lo[ks]):"v"(vb),"i"(d0*4096+ks*1024):"memory");
      asm volatile("ds_read_b64_tr_b16 %0,%1 offset:%c2":"=&v"(hi[ks]):"v"(vb),"i"(d0*4096+ks*1024+512):"memory");}
    asm volatile("s_waitcnt lgkmcnt(0)":::"memory");SBAR();
    #define PK(k) (bf16x8){lo[k][0],lo[k][1],lo[k][2],lo[k][3],hi[k][0],hi[k][1],hi[k][2],hi[k][3]}
    o[d0]=__builtin_amdgcn_mfma_f32_32x32x16_bf16(pa0,PK(0),o[d0],0,0,0);
    o[d0]=__builtin_amdgcn_mfma_f32_32x32x16_bf16(pa1,PK(1),o[d0],0,0,0);
    o[d0]=__builtin_amdgcn_mfma_f32_32x32x16_bf16(pa2,PK(2),o[d0],0,0,0);
    o[d0]=__builtin_amdgcn_mfma_f32_32x32x16_bf16(pa3,PK(3),o[d0],0,0,0);
    #undef PK
  }
}

#ifndef ATTN_STORE16
#define ATTN_STORE16(p,v) (*(u32x4*)(p)=(v))
#endif
template<int THRL> __device__ __forceinline__ void attn_unit(int b,int h,int qb,const bf16*Q,const bf16*__restrict__ K,const bf16*__restrict__ V,bf16*O,const float*__restrict__ CL,char*shm){
  const int tid=threadIdx.x,lane=tid&63,r32=lane&31,hi=lane>>5; const int wid=__builtin_amdgcn_readfirstlane(tid>>6);
  const long rowbase=(long)b*SEQ; const int q0=qb*QB;
  const bf16*Qw=Q+(rowbase+q0+wid*QBLK)*DM+h*D;
  const bf16*Kh=K+rowbase*DM+h*D,*Vh=V+rowbase*DM+h*D;
  const unsigned lds0=(unsigned)(uintptr_t)shm;
  float*wsf=(float*)(shm+LDS_WS)+wid*64;
  typedef __attribute__((address_space(3))) float lds_f32; typedef float f32x4_t __attribute__((ext_vector_type(4)));
  lds_f32*kbl3=(lds_f32*)((__attribute__((address_space(3))) char*)shm+LDS_KB);
  const float clq=-kbl3[qb*QB+wid*QBLK+(lane&31)];
  const bf16*ksrc=Kh+(long)lane*DM+wid*8;
  const bf16*vsrc=Vh+(long)(16*(wid&3)+(lane>>2))*DM+(wid>>2)*32+(lane&3)*8;
  const unsigned kdst=lds0+LDS_K+wid*1024, vdst=lds0+LDS_V+wid*1024;
  #define DMA_K(t,slot) glds16(ksrc+(long)(t)*KVBLK*DM,(unsigned)__builtin_amdgcn_readfirstlane(kdst+(slot)))
  #define DMA_V(t,slot) glds16(vsrc+(long)(t)*KVBLK*DM,(unsigned)__builtin_amdgcn_readfirstlane(vdst+(slot)))
  const int vb0=(int)(lds0+LDS_V)+((lane>>4)&1)*32+(lane&3)*8+(4*hi+((lane&15)>>2))*64;
  const char*Kbase=shm+LDS_K; bf16x8 kf[8];
  const lds_cptr shm3=(lds_cptr)shm; const lds_cptr kp0=shm3+LDS_K+hi*1024+r32*16; const lds_cptr vp0=shm3+LDS_V+((lane>>4)&1)*32+(lane&3)*8+(4*hi+((lane&15)>>2))*64;
  const int NT=(q0+QB)/KVBLK;
  DMA_K(0,0);DMA_V(0,0);DMA_K(1,SLOTB);
  bf16x8 qr[4];
  #pragma unroll
  for(int d0=0;d0<4;++d0)qr[d0]=*reinterpret_cast<const bf16x8*>(&Qw[(long)r32*DM+d0*16+hi*8]);
  float mhat=-clq,l_reg=0.f;f32x16 o[2];o[0]=f32x16{};o[1]=f32x16{};
  #define KINIT(X0,X1,t) do{ const __attribute__((address_space(3))) f32x4_t* kb_=(const __attribute__((address_space(3))) f32x4_t*)(kbl3+(t)*KVBLK+4*hi); \
    _Pragma("unroll") for(int g_=0;g_<4;++g_){ const f32x4_t ka_=kb_[2*g_], kc_=kb_[2*g_+8]; \
      X0[4*g_]=ka_[0]-mhat;X0[4*g_+1]=ka_[1]-mhat;X0[4*g_+2]=ka_[2]-mhat;X0[4*g_+3]=ka_[3]-mhat; X1[4*g_]=kc_[0]-mhat;X1[4*g_+1]=kc_[1]-mhat;X1[4*g_+2]=kc_[2]-mhat;X1[4*g_+3]=kc_[3]-mhat; } }while(0)
  const int qrel=wid*QBLK+r32;
  #define CMASK(P0,P1,t) do{int jb_=(t)-(NT-4); if(jb_>=0)cmask(P0,P1,jb_,qrel,hi);}while(0)
  bool resc=false;
  #define START(P0,P1) do{ const float rm=rowmax(P0,P1); resc=false; \
    { const float dl=rm; mhat=fadd_s(mhat,dl); \
      _Pragma("unroll") for(int r=0;r<16;++r){P0[r]=fsub_s(P0[r],dl);P1[r]=fsub_s(P1[r],dl);} \
      } \
    _Pragma("unroll") for(int r=0;r<16;++r)P0[r]=__builtin_amdgcn_exp2f(P0[r]); }while(0)
  #define RESC() do{ if(resc){ asm volatile("s_waitcnt lgkmcnt(0)":::"memory"); \
      _Pragma("unroll") for(int d_=0;d_<2;++d_) _Pragma("unroll") for(int r=0;r<16;++r)o[d_][r]*=wsf[crow(r,hi)]; } }while(0)
  f32x16 pA0,pA1,pB0,pB1;
  int sl_prev=0,sl_cur=0,sl_next=SLOTB;
  #define ROT() do{sl_prev=sl_cur;sl_cur=sl_next;sl_next=(sl_next==(NSLOT-1)*SLOTB)?0:sl_next+SLOTB;}while(0)
  DMA_K(2,2*SLOTB);
  WAIT_BAR(3);
  KINIT(pA0,pA1,0);qkt(pA0,pA1,Kbase,qr,r32,hi);asm volatile("s_nop 15\n\ts_nop 7":"+v"(pA0),"+v"(pA1));CMASK(pA0,pA1,0);
  START(pA0,pA1);
  _Pragma("unroll") for(int r=0;r<16;++r)pA1[r]=__builtin_amdgcn_exp2f(pA1[r]);
  KINIT(pB0,pB1,1);
  WAIT_BAR(0);
  DMA_K(3,0);DMA_V(1,SLOTB);
  ROT();
  kload8(kf,kp0+sl_cur);
  WAIT_BAR(2);
  s16x4 vlo[8],vhi[8]; u32x4 pw0,pw1,pw2,pw3;
  #define PKW(P,B) cvtpk_s(P[B],P[B+1])
  #define PAF(k) __builtin_bit_cast(bf16x8,pw##k)
  #define VFR(i) (bf16x8){vlo[i][0],vlo[i][1],vlo[i][2],vlo[i][3],vhi[i][0],vhi[i][1],vhi[i][2],vhi[i][3]}
  #define PIN(x) asm volatile("":"+v"(x))
  #define MX3(a,b,c) __builtin_fmaxf(__builtin_fmaxf((a),(b)),(c))
  #define GAPA(MF,A0,A1,A2,A3,W0,W1,PW) do{ MF; sacc+=A0; sacc+=A1; sacc+=A2; sacc+=A3; PIN(sacc); W0; W1; PIN(PW); SBAR(); }while(0)
  #define EX(v) __builtin_amdgcn_exp2f(v)
  #define GAPB(MF,X,B) do{ MF; X[B]=EX(X[B]); X[B+1]=EX(X[B+1]); X[B+2]=EX(X[B+2]); X[B+3]=EX(X[B+3]); PIN(X); SBAR(); }while(0)
  #define VRD(i) do{ vlo[i]=vtr(vp_+(((i)>>2)*4096+((i)&3)*1024)); vhi[i]=vtr(vp_+(((i)>>2)*4096+((i)&3)*1024+512)); }while(0)
  #define KRD(G,j) do{ if(G){ kload2(kf,kp0+sl_next,j); SBAR(); } }while(0)
  #define STEP(C0,C1,P0,P1,t,GK,GV,GL) do{ SBAR(); \
    const lds_cptr vp_=vp0+sl_prev; \
    VRD(0); SBAR(); float sacc=(P0[0]+P0[1]); \
    GAPA(C0=__builtin_amdgcn_mfma_f32_32x32x16_bf16(kf[0],qr[0],C0,0,0,0), P0[2],P0[3],P0[4],P0[5],     pw0[0]=PKW(P0,0), pw0[1]=PKW(P0,2), pw0); \
    VRD(4); SBAR(); GAPA(C1=__builtin_amdgcn_mfma_f32_32x32x16_bf16(kf[1],qr[0],C1,0,0,0), P0[6],P0[7],P0[8],P0[9],     pw0[2]=PKW(P0,4), pw0[3]=PKW(P0,6), pw0); \
    VRD(1); SBAR(); GAPA(C0=__builtin_amdgcn_mfma_f32_32x32x16_bf16(kf[2],qr[1],C0,0,0,0),   P0[10],P0[11],P0[12],P0[13], pw1[0]=PKW(P0,8), pw1[1]=PKW(P0,10), pw1); \
    VRD(5); SBAR(); GAPA(C1=__builtin_amdgcn_mfma_f32_32x32x16_bf16(kf[3],qr[1],C1,0,0,0),   P0[14],P0[15],P1[0],P1[1],   pw1[2]=PKW(P0,12),pw1[3]=PKW(P0,14), pw1); \
    VRD(2); SBAR(); GAPA(C0=__builtin_amdgcn_mfma_f32_32x32x16_bf16(kf[4],qr[2],C0,0,0,0),   P1[2],P1[3],P1[4],P1[5],     pw2[0]=PKW(P1,0), pw2[1]=PKW(P1,2), pw2); \
    VRD(6); SBAR(); GAPA(C1=__builtin_amdgcn_mfma_f32_32x32x16_bf16(kf[5],qr[2],C1,0,0,0),   P1[6],P1[7],P1[8],P1[9],     pw2[2]=PKW(P1,4), pw2[3]=PKW(P1,6), pw2); \
    VRD(3); SBAR(); GAPA(C0=__builtin_amdgcn_mfma_f32_32x32x16_bf16(kf[6],qr[3],C0,0,0,0),   P1[10],P1[11],P1[12],P1[13], pw3[0]=PKW(P1,8), pw3[1]=PKW(P1,10), pw3); \
    VRD(7); SBAR(); GAPA(C1=__builtin_amdgcn_mfma_f32_32x32x16_bf16(kf[7],qr[3],C1,0,0,0),   P1[14],P1[15],0.f,0.f,       pw3[2]=PKW(P1,12),pw3[3]=PKW(P1,14), pw3); \
    l_reg+=sacc; \
    if(GK){DMA_K((t)+3,sl_cur);} if(GV){DMA_V((t)+1,sl_next);} \
    CMASK(C0,C1,t); \
    { float a=MX3(C0[0],C0[1],C1[0]),b=MX3(C0[2],C0[3],C1[1]); a=MX3(a,C1[2],C1[3]); \
      _Pragma("unroll") for(int r=4;r<16;r+=4){a=MX3(a,C0[r],C0[r+1]);b=MX3(b,C0[r+2],C0[r+3]);a=MX3(a,C1[r],C1[r+1]);b=MX3(b,C1[r+2],C1[r+3]);} \
      float rm=__builtin_fmaxf(a,b); { auto rr=__builtin_amdgcn_permlane32_swap(__float_as_uint(rm),__float_as_uint(rm),false,false); rm=__builtin_fmaxf(__uint_as_float(rr[0]),__uint_as_float(rr[1])); } \
      resc=false; \
      if(__builtin_expect(__any(rm>(float)THRL),0)){ const float dl=__builtin_fmaxf(rm,0.f); mhat+=dl; \
        _Pragma("unroll") for(int r=0;r<16;++r){C0[r]-=dl;C1[r]-=dl;} \
        const float f=__builtin_amdgcn_exp2f(-dl); l_reg*=f; if(hi==0)wsf[r32]=f; resc=true; } } \
    SBAR(); \
    GAPB(o[0]=__builtin_amdgcn_mfma_f32_32x32x16_bf16(PAF(0),VFR(0),o[0],0,0,0), C0,0); \
    GAPB(o[1]=__builtin_amdgcn_mfma_f32_32x32x16_bf16(PAF(0),VFR(4),o[1],0,0,0), C0,4); \
    KRD(GL,0); GAPB(o[0]=__builtin_amdgcn_mfma_f32_32x32x16_bf16(PAF(1),VFR(1),o[0],0,0,0), C0,8); \
    KRD(GL,1); GAPB(o[1]=__builtin_amdgcn_mfma_f32_32x32x16_bf16(PAF(1),VFR(5),o[1],0,0,0), C0,12); \
    KRD(GL,2); GAPB(o[0]=__builtin_amdgcn_mfma_f32_32x32x16_bf16(PAF(2),VFR(2),o[0],0,0,0), C1,0); \
    KRD(GL,3); GAPB(o[1]=__builtin_amdgcn_mfma_f32_32x32x16_bf16(PAF(2),VFR(6),o[1],0,0,0), C1,4); \
    GAPB(o[0]=__builtin_amdgcn_mfma_f32_32x32x16_bf16(PAF(3),VFR(3),o[0],0,0,0), C1,8); \
    GAPB(o[1]=__builtin_amdgcn_mfma_f32_32x32x16_bf16(PAF(3),VFR(7),o[1],0,0,0), C1,12); \
    if(GV){ KINIT(P0,P1,(t)+1); } \
    }while(0)
  int t=1;
  #undef CMASK
  #define CMASK(P0,P1,t) do{}while(0)
  for(;t+5<NT;t+=2){
    STEP(pB0,pB1,pA0,pA1,t,true,true,true);     WAIT_BAR(2); RESC(); ROT();
    STEP(pA0,pA1,pB0,pB1,t+1,true,true,true);   WAIT_BAR(2); RESC(); ROT();
  }
  #undef CMASK
  #define CMASK(P0,P1,t) do{int jb_=(t)-(NT-4); if(jb_>=0)cmask(P0,P1,jb_,qrel,hi);}while(0)
  #define ENDW(tt) do{ if((tt)+3<NT){WAIT_BAR(2);} else if((tt)+2<NT){WAIT_BAR(1);} else {WAIT_BAR(0);} }while(0)
  for(;t+1<NT;t+=2){
    STEP(pB0,pB1,pA0,pA1,t,(t+3<NT),(t+1<NT),(t+1<NT));       ENDW(t);   RESC(); ROT();
    STEP(pA0,pA1,pB0,pB1,t+1,(t+4<NT),(t+2<NT),(t+2<NT));     ENDW(t+1); RESC(); ROT();
  }
  STEP(pB0,pB1,pA0,pA1,NT-1,false,false,false); RESC();
  { float sacc=pB0[0]+pB0[1]; _Pragma("unroll") for(int r=2;r<16;++r)sacc+=pB0[r]; _Pragma("unroll") for(int r=0;r<16;++r)sacc+=pB1[r]; l_reg+=sacc;
    pw0=(u32x4){PKW(pB0,0),PKW(pB0,2),PKW(pB0,4),PKW(pB0,6)};pw1=(u32x4){PKW(pB0,8),PKW(pB0,10),PKW(pB0,12),PKW(pB0,14)};pw2=(u32x4){PKW(pB1,0),PKW(pB1,2),PKW(pB1,4),PKW(pB1,6)};pw3=(u32x4){PKW(pB1,8),PKW(pB1,10),PKW(pB1,12),PKW(pB1,14)};
    SBAR(); pv(o,vb0+sl_cur,PAF(0),PAF(1),PAF(2),PAF(3)); }
  #undef PKW
  #undef PAF
  #undef VFR
  #undef PIN
  #undef MX3
  #undef GAPA
  #undef GAPB
  #undef EX
  #undef VRD
  #undef KRD
  #undef STEP
  #undef ENDW
  {auto rr=__builtin_amdgcn_permlane32_swap(__float_as_uint(l_reg),__float_as_uint(l_reg),false,false);l_reg=__uint_as_float(rr[0])+__uint_as_float(rr[1]);}
  if(hi==0)wsf[32+r32]=l_reg;asm volatile("s_waitcnt lgkmcnt(0)":::"memory");
  float rli[16];
  #pragma unroll
  for(int r=0;r<16;++r)rli[r]=__builtin_amdgcn_rcpf(wsf[32+crow(r,hi)]);
  bf16*Ow=O+(rowbase+q0+wid*QBLK)*OPITCH+h*D;
  { bf16*stg=(bf16*)(shm+LDS_OST)+wid*2048;
    #pragma unroll
    for(int r=0;r<16;++r){const int orow=crow(r,hi);
      #pragma unroll
      for(int d0=0;d0<2;++d0)stg[orow*64+d0*32+r32]=__float2bfloat16(o[d0][r]*rli[r]);}
    asm volatile("s_waitcnt lgkmcnt(0)":::"memory");
    #pragma unroll
    for(int i=0;i<4;++i){const int row=i*8+(lane>>3),ch=lane&7; const u32x4 v=*(const u32x4*)(stg+row*64+ch*8); ATTN_STORE16(Ow+(long)row*OPITCH+ch*8,v);} }
  asm volatile("s_waitcnt lgkmcnt(0)\n\ts_barrier":::"memory");
  #undef KINIT
  #undef DMA_K
  #undef DMA_V
  #undef CMASK
  #undef START
  #undef RESC
  #undef ROT
}
constexpr int ATTN_LDS_BYTES=LDS_BYTES;
struct AttnTensors { const bf16* Q; const bf16* K; const bf16* V; bf16* O; const float* CL; };
struct AttnUnit { int bh; int qb; };
struct StaticOrder {
  int vcu, G;
  __device__ __forceinline__ explicit StaticOrder(int grid,int v):vcu(v),G(grid){}
  __device__ __forceinline__ bool next(int i,AttnUnit&u)const{ const int bh=vcu+(i/NQB)*G; if(bh>=BATCH*NHEAD)return false; u.bh=bh; u.qb=NQB-1-(i%NQB); return true; }
  __device__ __forceinline__ void a_ready(const AttnUnit&)const{}
  __device__ __forceinline__ void done(const AttnUnit&)const{}
};
__device__ __forceinline__ void build_bias(int b,int h,const float*__restrict__ LOGF,char*shm){
  typedef __attribute__((address_space(3))) float lds_f32; typedef float f32x4_t __attribute__((ext_vector_type(4)));
  const int tid=threadIdx.x,lane=tid&63; const int wid=__builtin_amdgcn_readfirstlane(tid>>6);
  lds_f32*kbl3=(lds_f32*)((__attribute__((address_space(3))) char*)shm+LDS_KB); lds_f32*wtot=(lds_f32*)((__attribute__((address_space(3))) char*)shm+LDS_WS);
  const float*src=LOGF+((long)b*SEQ+4*tid)*NHEAD+h;
  float a0=src[0],a1=src[NHEAD],a2=src[2*NHEAD],a3=src[3*NHEAD]; a1+=a0;a2+=a1;a3+=a2;
  float inc=a3;
  #pragma unroll
  for(int o=1;o<64;o<<=1){ const float t=__shfl_up(inc,o); if(lane>=o)inc+=t; }
  if(lane==63)wtot[wid]=inc;
  asm volatile("s_waitcnt lgkmcnt(0)\n\ts_barrier":::"memory");
  float base=0.f;
  #pragma unroll
  for(int w=0;w<NW;++w){ const float t=wtot[w]; if(w<wid)base+=t; }
  const float ex=base+inc-a3; const float c=-1.4426950408889634f;
  *(__attribute__((address_space(3))) f32x4_t*)(kbl3+4*tid)=(f32x4_t){(ex+a0)*c,(ex+a1)*c,(ex+a2)*c,(ex+a3)*c};
  asm volatile("s_waitcnt lgkmcnt(0)\n\ts_barrier":::"memory");
}
template<class Sched,int THRL=8> __device__ __forceinline__ void attn_phase(char*lds,const AttnTensors&T,const Sched&S){
  AttnUnit u; int cur_bh=-1;
  for(int i=0;S.next(i,u);++i){ if(u.bh!=cur_bh){ build_bias(u.bh/NHEAD,u.bh%NHEAD,T.CL,lds); cur_bh=u.bh; }
    S.a_ready(u); attn_unit<THRL>(u.bh/NHEAD,u.bh%NHEAD,u.qb,T.Q,T.K,T.V,T.O,T.CL,lds); S.done(u); }
}
#undef SBAR
#undef WAIT_BAR
}
namespace memattn {
using attn_body::bf16x8; using attn_body::f32x16; using attn_body::s16x4; using attn_body::u32x4;
#define MLAS __attribute__((address_space(3)))
constexpr int KSTR = 272, VSTR = 520, K_OFF = 0, V_OFF = 256 * KSTR, WSF_OFF = V_OFF + 128 * VSTR, MEM_LDS_BYTES = WSF_OFF + 8 * 256;
__device__ __forceinline__ void stage_kv(int b, int hm, const unsigned short* KM, const unsigned short* VT, const float* kgain, MLAS unsigned char* L) {
    int tid = threadIdx.x; asm volatile("" : "+v"(tid));
    { const int c = tid & 15, r0 = tid >> 4;
      const unsigned short* src = KM + ((long)b * 256 + r0) * 512 + hm * 128 + c * 8;
      float g[8];
#pragma unroll
      for (int j = 0; j < 8; ++j) g[j] = kgain[c * 8 + j];
      u32x4 vv[8];
#pragma unroll
      for (int p = 0; p < 8; ++p) vv[p] = *reinterpret_cast<const u32x4*>(src + (long)p * 32 * 512);
#pragma unroll
      for (int p = 0; p < 8; ++p) { const u32x4 v = vv[p];
          float f[8] = {__uint_as_float(v.x << 16), __uint_as_float(v.x & 0xffff0000u), __uint_as_float(v.y << 16), __uint_as_float(v.y & 0xffff0000u), __uint_as_float(v.z << 16), __uint_as_float(v.z & 0xffff0000u), __uint_as_float(v.w << 16), __uint_as_float(v.w & 0xffff0000u)};
          float ss = 0.f;
#pragma unroll
          for (int j = 0; j < 8; ++j) ss += f[j] * f[j];
          ss += __int_as_float(__builtin_amdgcn_ds_swizzle(__float_as_int(ss), (1 << 10) | 0x1f)); ss += __int_as_float(__builtin_amdgcn_ds_swizzle(__float_as_int(ss), (2 << 10) | 0x1f));
          ss += __int_as_float(__builtin_amdgcn_ds_swizzle(__float_as_int(ss), (4 << 10) | 0x1f)); ss += __int_as_float(__builtin_amdgcn_ds_swizzle(__float_as_int(ss), (8 << 10) | 0x1f));
          const float r = 1.0f / sqrtf(ss * (1.0f / 128.0f) + 1e-6f);
          u32x4 o; o.x = attn_body::cvtpk_s(f[0] * r * g[0], f[1] * r * g[1]); o.y = attn_body::cvtpk_s(f[2] * r * g[2], f[3] * r * g[3]); o.z = attn_body::cvtpk_s(f[4] * r * g[4], f[5] * r * g[5]); o.w = attn_body::cvtpk_s(f[6] * r * g[6], f[7] * r * g[7]);
          *(MLAS u32x4*)(L + K_OFF + (p * 32 + r0) * KSTR + c * 16) = o; } }
    { const int c = tid & 31, r0 = tid >> 5;
      typedef unsigned u32x2_t __attribute__((ext_vector_type(2)));
      const unsigned short* src = VT + ((long)hm * 128 + r0) * 4096 + b * 256 + c * 8;
#pragma unroll
      for (int p = 0; p < 8; ++p) { const u32x4 v = *reinterpret_cast<const u32x4*>(src + (long)p * 16 * 4096); MLAS unsigned char* d = L + V_OFF + (p * 16 + r0) * VSTR + c * 16;
          *(MLAS u32x2_t*)d = (u32x2_t){v.x, v.y}; *(MLAS u32x2_t*)(d + 8) = (u32x2_t){v.z, v.w}; } }
}
__device__ __forceinline__ void unit(int b, int hm, int qb, const unsigned short* QM, unsigned short* OM, MLAS unsigned char* L) {
    int tid = threadIdx.x; asm volatile("" : "+v"(tid)); const int lane = tid & 63, r32 = lane & 31, hi = lane >> 5; const int wid = __builtin_amdgcn_readfirstlane(tid >> 6);
    const long row0 = (long)b * 2048 + qb * 256 + wid * 32;
    const unsigned short* Qw = QM + (row0 + r32) * 512 + hm * 128 + hi * 8;
    bf16x8 qr[8];
#pragma unroll
    for (int d0 = 0; d0 < 8; ++d0) qr[d0] = *reinterpret_cast<const bf16x8*>(Qw + d0 * 16);
    const MLAS unsigned char* Kb = L + K_OFF + r32 * KSTR + hi * 16;
    f32x16 s[8];
#pragma unroll
    for (int kb = 0; kb < 8; ++kb) { f32x16 a = f32x16{};
#pragma unroll
        for (int d0 = 0; d0 < 8; ++d0) { const bf16x8 kf = *(const MLAS bf16x8*)(Kb + kb * 32 * KSTR + d0 * 32); a = __builtin_amdgcn_mfma_f32_32x32x16_bf16(kf, qr[d0], a, 0, 0, 0); }
        s[kb] = a; }
    float mx = s[0][0];
#pragma unroll
    for (int kb = 0; kb < 8; ++kb)
#pragma unroll
        for (int r = 0; r < 16; ++r) mx = fmaxf(mx, s[kb][r]);
    { auto rr_ = __builtin_amdgcn_permlane32_swap(__float_as_uint(mx), __float_as_uint(mx), false, false); mx = fmaxf(__uint_as_float(rr_[0]), __uint_as_float(rr_[1])); }
    float l = 0.f;
#pragma unroll
    for (int kb = 0; kb < 8; ++kb)
#pragma unroll
        for (int r = 0; r < 16; ++r) { const float e = __builtin_amdgcn_exp2f(s[kb][r] - mx); s[kb][r] = e; l += e; }
    { auto rr_ = __builtin_amdgcn_permlane32_swap(__float_as_uint(l), __float_as_uint(l), false, false); l = __uint_as_float(rr_[0]) + __uint_as_float(rr_[1]); }
    u32x4 pw[16];
#pragma unroll
    for (int ks = 0; ks < 16; ++ks) { const int kb = ks >> 1, h8 = (ks & 1) * 8;
        pw[ks].x = attn_body::cvtpk_s(s[kb][h8 + 0], s[kb][h8 + 1]); pw[ks].y = attn_body::cvtpk_s(s[kb][h8 + 2], s[kb][h8 + 3]); pw[ks].z = attn_body::cvtpk_s(s[kb][h8 + 4], s[kb][h8 + 5]); pw[ks].w = attn_body::cvtpk_s(s[kb][h8 + 6], s[kb][h8 + 7]); }
#pragma unroll
    for (int ks = 0; ks < 16; ++ks) asm volatile("" : "+v"(pw[ks]));
    asm volatile("" ::: "memory");
    const MLAS unsigned char* Vb = L + V_OFF + r32 * VSTR + hi * 8;
    f32x16 o[4]; o[0] = f32x16{}; o[1] = f32x16{}; o[2] = f32x16{}; o[3] = f32x16{};
#pragma unroll
    for (int ks = 0; ks < 16; ++ks) { const bf16x8 pa = __builtin_bit_cast(bf16x8, pw[ks]);
#pragma unroll
        for (int db = 0; db < 4; ++db) { const MLAS unsigned char* vp = Vb + db * 32 * VSTR + ks * 32;
            const s16x4 lo = *(const MLAS s16x4*)vp, h4 = *(const MLAS s16x4*)(vp + 16);
            const bf16x8 vf = (bf16x8){lo[0], lo[1], lo[2], lo[3], h4[0], h4[1], h4[2], h4[3]};
            o[db] = __builtin_amdgcn_mfma_f32_32x32x16_bf16(vf, pa, o[db], 0, 0, 0); } }
    const float rl = __builtin_amdgcn_rcpf(l);
    unsigned short* Orow = OM + (row0 + r32) * 2048 + hm * 128 + hi * 8;
#pragma unroll
    for (int db = 0; db < 4; ++db)
#pragma unroll
        for (int pr = 0; pr < 2; ++pr) {
            unsigned ax = attn_body::cvtpk_s(o[db][8 * pr + 0] * rl, o[db][8 * pr + 1] * rl), ay = attn_body::cvtpk_s(o[db][8 * pr + 2] * rl, o[db][8 * pr + 3] * rl);
            unsigned bx = attn_body::cvtpk_s(o[db][8 * pr + 4] * rl, o[db][8 * pr + 5] * rl), by = attn_body::cvtpk_s(o[db][8 * pr + 6] * rl, o[db][8 * pr + 7] * rl);
            { auto r_ = __builtin_amdgcn_permlane32_swap(ax, bx, false, false); ax = r_[0]; bx = r_[1]; }
            { auto r_ = __builtin_amdgcn_permlane32_swap(ay, by, false, false); ay = r_[0]; by = r_[1]; }
            *(u32x4*)(Orow + db * 32 + pr * 16) = (u32x4){ax, ay, bx, by}; }
    asm volatile("s_waitcnt lgkmcnt(0)" ::: "memory");
}
#undef MLAS
}

constexpr int NWAVES = 8;
#ifndef MK_N_LAUNCHES
#define MK_N_LAUNCHES 1
#endif
constexpr int NPH = 12;
#ifndef PROBE_DOUBLE_MASK
#define PROBE_DOUBLE_MASK 0
#endif
constexpr int B_ = 16, S_ = 2048, DM_ = 2048, M_ = B_ * S_, FF_ = 5632, MEML = 256, MM_ = B_ * MEML;
constexpr int NWIN = 10496, NWIN_SRC = 10256;
constexpr float EPS_ = 1e-6f, LOG2E = 1.4426950408889634f;
constexpr size_t MiB = 1u << 20;
constexpr size_t WS_GU = 1 * MiB, WS_DN = 45 * MiB, WS_WIN = 67 * MiB, WS_WMKV = 108 * MiB, WS_WCAT = 112 * MiB, WS_WO = 120 * MiB;
constexpr size_t WS_H = 128 * MiB;
constexpr size_t WS_MEMN = 256 * MiB, WS_KM = 272 * MiB, WS_VT = 276 * MiB, WS_LOGF = 280 * MiB, WS_CL = 282 * MiB;
constexpr size_t WS_BIG = 284 * MiB;
constexpr size_t WS_UP = WS_BIG, WS_PD = WS_BIG + 32 * MiB, WS_QF = WS_BIG + 64 * MiB, WS_KF = WS_BIG + 128 * MiB, WS_VF = WS_BIG + 192 * MiB, WS_QM = WS_BIG + 256 * MiB, WS_GATE = WS_BIG + 288 * MiB;
constexpr size_t WS_END = WS_GATE + 384 * MiB;
constexpr size_t WS_BAR = 512 * 1024, WS_BAR_BYTES = 16384;
constexpr size_t WS_SSQ1 = 0, WS_SSQ2 = 256 * 1024;
constexpr size_t WS_H3 = WS_BIG + 352 * MiB;
static_assert(WS_BIG + (size_t)M_ * FF_ * 2 <= WS_END && WS_WO + 8 * MiB <= WS_H && WS_WIN + (size_t)NWIN * DM_ * 2 <= WS_WMKV, "d_ws map");
constexpr int RING_BYTES = 131072, LDS_BYTES = 147456;
static_assert(attn_body::ATTN_LDS_BYTES <= RING_BYTES && memattn::MEM_LDS_BYTES <= LDS_BYTES, "attention scratch fits");

#define GAS __attribute__((address_space(1)))
#define LAS __attribute__((address_space(3)))
typedef unsigned short bf16;
typedef unsigned v4u __attribute__((ext_vector_type(4)));
typedef unsigned v2u __attribute__((ext_vector_type(2)));
typedef float f32x4 __attribute__((ext_vector_type(4)));
#define LDS_WAIT() asm volatile("s_waitcnt lgkmcnt(0)" ::: "memory")
__device__ __forceinline__ unsigned f2bf(float f) { unsigned u = __builtin_bit_cast(unsigned, f); return (u + 0x7fffu + ((u >> 16) & 1u)) >> 16; }
__device__ __forceinline__ unsigned pk2(float lo, float hi) { return f2bf(lo) | (f2bf(hi) << 16); }
__device__ __forceinline__ float wave_sum(float v) {
#pragma unroll
    for (int o = 1; o < 64; o <<= 1) v += __shfl_xor(v, o);
    return v;
}
__device__ __forceinline__ int dmap(int map, int n) {
    if (map == 1) { const int up = n >= FF_ ? 1 : 0; const int c = up ? n - FF_ : n; return (c >> 7) * 256 + up * 128 + (c & 127); }
    if (map == 2) { return n < 3584 ? n : (n < 3600 ? 10240 + (n - 3584) : n - 16); }
    return n;
}
__device__ __forceinline__ float colscale(int map, int n) {
    if (map == 1) return n < FF_ ? LOG2E : (1.0f / LOG2E);
    if (map == 2) return n >= 4112 ? LOG2E : 1.0f;
    return 1.0f;
}
constexpr int TSCR = 64 * 65 * 4;
__device__ __forceinline__ void transpose_item(const float* W, int K, int N, bf16* WT, int map, LAS float* scr, int item, int lane, int ldk = 0, int koff = 0, const float* kgain = nullptr) {
    if (ldk == 0) ldk = K;
    const int nblk = (N + 63) / 64, kb = item / nblk, nb = item % nblk, k0 = 64 * kb, n0 = 64 * nb;
    const int kq = lane >> 4, c = lane & 15, nc = n0 + 4 * c; const bool okc = nc < N;
    f32x4 v[16];
    const float* src = W + (size_t)(k0 + kq) * N + nc;
#pragma unroll
    for (int i = 0; i < 16; ++i) v[i] = okc ? *(const f32x4*)(src + (size_t)(4 * i) * N) : (f32x4){0.f, 0.f, 0.f, 0.f};
#pragma unroll
    for (int i = 0; i < 16; ++i) { LAS float* d = scr + (4 * i + kq) * 65 + 4 * c; const float kg = kgain ? kgain[k0 + 4 * i + kq] : 1.0f;
        d[0] = v[i].x * kg; d[1] = v[i].y * kg; d[2] = v[i].z * kg; d[3] = v[i].w * kg; }
    LDS_WAIT(); asm volatile("" ::: "memory");
    const int cc = lane & 7, nn = lane >> 3;
#pragma unroll
    for (int j = 0; j < 8; ++j) { const int n = nn + 8 * j; const LAS float* s = scr + (8 * cc) * 65 + n; const float cs = colscale(map, n0 + n);
        v4u o; o.x = pk2(s[0 * 65] * cs, s[1 * 65] * cs); o.y = pk2(s[2 * 65] * cs, s[3 * 65] * cs); o.z = pk2(s[4 * 65] * cs, s[5 * 65] * cs); o.w = pk2(s[6 * 65] * cs, s[7 * 65] * cs);
        if (n0 + n < N) *(v4u*)(WT + (size_t)dmap(map, n0 + n) * ldk + koff + k0 + 8 * cc) = o; }
    LDS_WAIT(); asm volatile("" ::: "memory");
}
__device__ __forceinline__ int transpose_items(int K, int N) { return (K / 64) * ((N + 63) / 64); }
__device__ __forceinline__ void norm_row(const float* xrow, const float* gain, bf16* orow, int lane) {
    const f32x4* xr = (const f32x4*)xrow + lane; const f32x4* gr = (const f32x4*)gain + lane;
    f32x4 v[8]; float s = 0.f;
#pragma unroll
    for (int j = 0; j < 8; ++j) { v[j] = xr[64 * j]; s += (v[j].x * v[j].x + v[j].y * v[j].y) + (v[j].z * v[j].z + v[j].w * v[j].w); }
    const float r = 1.0f / sqrtf(wave_sum(s) * (1.0f / 2048.0f) + EPS_);
    v2u* o8 = (v2u*)orow + lane;
#pragma unroll
    for (int j = 0; j < 8; ++j) { const f32x4 g = gr[64 * j]; v2u w; w.x = pk2(v[j].x * r * g.x, v[j].y * r * g.y); w.y = pk2(v[j].z * r * g.z, v[j].w * r * g.w); o8[64 * j] = w; }
}
__device__ __forceinline__ void headnorm(bf16* X, int rows, int W, int HD, const float* gain, float scale, int gtid, int NT) {
    const int cpr = W / 8; const long total = (long)rows * cpr;
    for (long base = gtid; base < total; base += 4l * NT) {
        v4u v[4];
#pragma unroll
        for (int k = 0; k < 4; ++k) { const long idx = base + (long)k * NT; if (idx < total) v[k] = *(const v4u*)(X + idx * 8); }
#pragma unroll
        for (int k = 0; k < 4; ++k) { const long idx = base + (long)k * NT; if (idx < total) { const int ch = (int)(idx % cpr);
            float f[8] = {pg8::bf_lo(v[k].x), pg8::bf_hi(v[k].x), pg8::bf_lo(v[k].y), pg8::bf_hi(v[k].y), pg8::bf_lo(v[k].z), pg8::bf_hi(v[k].z), pg8::bf_lo(v[k].w), pg8::bf_hi(v[k].w)};
            float ss = 0.f;
#pragma unroll
            for (int j = 0; j < 8; ++j) ss += f[j] * f[j];
            ss += __shfl_xor(ss, 1); ss += __shfl_xor(ss, 2); ss += __shfl_xor(ss, 4); if (HD == 128) ss += __shfl_xor(ss, 8);
            const float r = scale / sqrtf(ss / (float)HD + EPS_);
            const float* g = gain + ((ch * 8) % HD);
            v4u o; o.x = pk2(f[0] * r * g[0], f[1] * r * g[1]); o.y = pk2(f[2] * r * g[2], f[3] * r * g[3]); o.z = pk2(f[4] * r * g[4], f[5] * r * g[5]); o.w = pk2(f[6] * r * g[6], f[7] * r * g[7]);
            *(v4u*)(X + idx * 8) = o; } } }
}

#define XB_TMO      128
#define XB_XCNT(j)  (256  + 64 * (j))
#define XB_XSUB(j)  (1280 + 64 * (j))
#define XB_XGEN(j)  (2304 + 64 * (j))
#define XB_TOP      3328
#define XB_TOPGEN   3392
#define XCD_BAR_WORDS 3456
#define XB_SPIN_CAP (1u << 18)

__device__ __forceinline__ unsigned xb_ld(unsigned* p)              { return __hip_atomic_load(p, __ATOMIC_RELAXED, __HIP_MEMORY_SCOPE_AGENT); }
__device__ __forceinline__ unsigned xb_add(unsigned* p, unsigned v) { return __hip_atomic_fetch_add(p, v, __ATOMIC_RELAXED, __HIP_MEMORY_SCOPE_AGENT); }
__device__ __forceinline__ unsigned xb_xcc_id() { return (unsigned)__builtin_amdgcn_s_getreg((3 << 11) | 20) & 0xFu; }
#define XB_SPIN(cond, bar) do { unsigned _sp = 0; while (cond) { __builtin_amdgcn_s_sleep(1); \
    if ((++_sp & 255u) == 0u) { if (xb_ld(&(bar)[XB_TMO])) break; if (_sp > XB_SPIN_CAP) { atomicAdd(&(bar)[XB_TMO], 1u); break; } } } } while (0)

struct XcdBarrier {
    unsigned* bar; unsigned x;
    volatile LAS unsigned* st;
};

__device__ __forceinline__ XcdBarrier xcd_barrier_post(unsigned* bar, volatile LAS unsigned* st) {
    XcdBarrier b; b.bar = bar; b.x = xb_xcc_id(); b.st = st;
    if (threadIdx.x == 0) (void)xb_add(&bar[XB_XCNT(b.x)], 1u);
    return b;
}
__device__ __forceinline__ void xcd_barrier_complete(unsigned* bar, unsigned x, unsigned& nloc, unsigned& nx) {
    const unsigned G = gridDim.x * gridDim.y * gridDim.z;
    unsigned sum, cnt, mine, sp = 0u;
    for (;;) {
        sum = 0u; cnt = 0u; mine = 0u;
#pragma unroll
        for (unsigned j = 0; j < 16; ++j) { const unsigned c = xb_ld(&bar[XB_XCNT(j)]); sum += c; cnt += (c > 0u) ? 1u : 0u; mine = (j == x) ? c : mine; }
        if (sum == G) break;
        __builtin_amdgcn_s_sleep(1);
        if ((++sp & 255u) == 0u) { if (xb_ld(&bar[XB_TMO])) break; if (sp > XB_SPIN_CAP) { atomicAdd(&bar[XB_TMO], 1u); break; } }
    }
    nloc = mine > 0u ? mine : 1u; nx = cnt > 0u ? cnt : 1u;
}

__device__ __forceinline__ void xcd_barrier(const XcdBarrier& b) {
    asm volatile("s_waitcnt vmcnt(0)" ::: "memory");
    __syncthreads();
    if (threadIdx.x == 0) {
        unsigned* bar = b.bar;
        __builtin_amdgcn_s_waitcnt(0);
        unsigned nloc = b.st[0], nx = b.st[1];
        if (nloc == 0u) { xcd_barrier_complete(bar, b.x, nloc, nx); b.st[0] = nloc; b.st[1] = nx; }
        const unsigned old = xb_add(&bar[XB_XSUB(b.x)], 1u);
        const unsigned gen = old / nloc;
        if (old + 1u == (gen + 1u) * nloc) {
            __builtin_amdgcn_fence(__ATOMIC_RELEASE, "agent");
            asm volatile("s_waitcnt vmcnt(0)" ::: "memory");
            const unsigned og = xb_add(&bar[XB_TOP], 1u);
            const unsigned tg = og / nx;
            if (og + 1u == (tg + 1u) * nx) xb_add(&bar[XB_TOPGEN], 1u);
            else XB_SPIN(xb_ld(&bar[XB_TOPGEN]) == tg, bar);
            __builtin_amdgcn_fence(__ATOMIC_ACQUIRE, "agent");
            xb_add(&bar[XB_XGEN(b.x)], 1u);
            asm volatile("s_waitcnt vmcnt(0)" ::: "memory");
        } else {
            XB_SPIN(xb_ld(&bar[XB_XGEN(b.x)]) == gen, bar);
            __builtin_amdgcn_fence(__ATOMIC_ACQUIRE, "agent");
            asm volatile("s_waitcnt vmcnt(0)" ::: "memory");
        }
    }
    __syncthreads();
}

struct Args { const float* in[23]; float* out; unsigned char* ws; int ph_lo, ph_hi; };

__global__ void __launch_bounds__(NWAVES * 64, 2) mk_fwd(Args args) {
    __builtin_assume(__builtin_amdgcn_workitem_id_y() == 0); __builtin_assume(__builtin_amdgcn_workitem_id_z() == 0);
    extern __shared__ __attribute__((aligned(16))) unsigned char lds[];
    LAS unsigned char* L = (LAS unsigned char*)lds;
    const int tid = threadIdx.x, lane = tid & 63, wave = __builtin_amdgcn_readfirstlane(tid >> 6);
    const int G = gridDim.x, bx = blockIdx.x, vcu = (G % 8 == 0) ? (bx % 8) * (G / 8) + bx / 8 : bx;
    const int gw = vcu * NWAVES + wave, NGW = G * NWAVES, gtid = gw * 64 + lane, NT = NGW * 64;
    unsigned char* ws = args.ws;
    if (tid < 16) ((LAS unsigned*)(L + LDS_BYTES - 64))[tid] = 0u;
    __syncthreads();
    const XcdBarrier gbar = xcd_barrier_post((unsigned*)(ws + WS_BAR), (volatile LAS unsigned*)(L + LDS_BYTES - 64));
    LAS float* scr = (LAS float*)(L + wave * TSCR);

    const int lo = args.ph_lo, hi = args.ph_hi;
#define IN(k) (lo <= (k) && (k) < hi)
#define SEAM(k) do { if ((k) + 1 < hi) { xcd_barrier(gbar); } } while (0)
#define GEMM(EPI, g, E, crot) do { pg8::StaticOrder S_; S_.init((g).M, (g).N, G, (bx + (crot)) % G); pg8::gemm_phase<EPI, pg8::StaticOrder, true, true>(L, g, S_, E); } while (0)

    if (IN(0)) {
        const int i0 = transpose_items(2048, 11264), i1 = transpose_items(5632, 2048), i2 = transpose_items(2048, NWIN_SRC), i3 = transpose_items(1024, 2048), i4 = transpose_items(2048, 1024),
                  i5 = transpose_items(512, 2048), i6 = transpose_items(2048, 2048);
        const int total = i0 + i1 + i2 + i3 + i4 + i5 + i6;
        for (int it = gw; it < total; it += NGW) { int r = it;
            if (r < i0) { transpose_item(args.in[3], 2048, 11264, (bf16*)(ws + WS_GU), 1, scr, r, lane); continue; } r -= i0;
            if (r < i1) { transpose_item(args.in[4], 5632, 2048, (bf16*)(ws + WS_DN), 0, scr, r, lane); continue; } r -= i1;
            if (r < i2) { transpose_item(args.in[7], 2048, NWIN_SRC, (bf16*)(ws + WS_WIN), 2, scr, r, lane, 0, 0, args.in[5]); continue; } r -= i2;
            if (r < i3) { transpose_item(args.in[14], 1024, 2048, (bf16*)(ws + WS_WCAT), 0, scr, r, lane, 2048, 512); continue; } r -= i3;
            if (r < i4) { transpose_item(args.in[15], 2048, 1024, (bf16*)(ws + WS_WMKV), 0, scr, r, lane); continue; } r -= i4;
            if (r < i5) { transpose_item(args.in[18], 512, 2048, (bf16*)(ws + WS_WCAT), 0, scr, r, lane, 2048, 1536); continue; } r -= i5;
            transpose_item(args.in[19], 2048, 2048, (bf16*)(ws + WS_WO), 0, scr, r, lane); }
        for (int i = gtid; i < 2 * M_; i += NT) { ((float*)(ws + WS_SSQ1))[i < M_ ? i : i - M_ + (int)((WS_SSQ2 - WS_SSQ1) / 4)] = 0.f; }
        for (int i = gtid; i < 240 * 256; i += NT) *(v4u*)(ws + WS_WIN + (size_t)10256 * 4096 + (size_t)i * 16) = (v4u){0u, 0u, 0u, 0u};
        { const float* pw = args.in[9]; const float* ps = args.in[10]; const float* wpu = args.in[11]; bf16* WP = (bf16*)(ws + WS_WCAT);
          for (int it = gw; it < 2048; it += NGW) { const int nb = it >> 6, cc = it & 63, g = cc >> 4, c0 = (cc & 15) * 8, n = nb * 64 + lane;
            float a0 = 0.f, a1 = 0.f, a2 = 0.f, a3 = 0.f, a4 = 0.f, a5 = 0.f, a6 = 0.f, a7 = 0.f;
            const float* pr = pw + (size_t)(g * 128 + c0) * 128;
#pragma unroll 16
            for (int d = 0; d < 128; ++d) { const float wv = ps[g * 128 + d] * wpu[(size_t)(g * 128 + d) * 2048 + n];
                a0 += pr[d] * wv; a1 += pr[128 + d] * wv; a2 += pr[256 + d] * wv; a3 += pr[384 + d] * wv; a4 += pr[512 + d] * wv; a5 += pr[640 + d] * wv; a6 += pr[768 + d] * wv; a7 += pr[896 + d] * wv; }
            v4u o; o.x = pk2(a0, a1); o.y = pk2(a2, a3); o.z = pk2(a4, a5); o.w = pk2(a6, a7);
            *(v4u*)(WP + (size_t)n * 2048 + cc * 8) = o; } }
        for (int m = gw; m < M_; m += NGW) norm_row(args.in[0] + (size_t)m * 2048, args.in[2], (bf16*)(ws + WS_H) + (size_t)m * 2048, lane);
        for (int m = gw; m < MM_; m += NGW) norm_row(args.in[1] + (size_t)m * 2048, args.in[6], (bf16*)(ws + WS_MEMN) + (size_t)m * 2048, lane);
        SEAM(0);
    }
    if (IN(1)) {
        __syncthreads();
        { const pg8::Gemm g{(const bf16*)(ws + WS_H), (const bf16*)(ws + WS_GU), M_, 2 * FF_, 2048}; const pg8::EpiSwiGLU E{(bf16*)(ws + WS_BIG), FF_, nullptr}; GEMM(pg8::EpiSwiGLU, g, E, 0); }
        SEAM(1);
    }
    if (IN(2)) {
        __syncthreads();
        { const pg8::Gemm g{(const bf16*)(ws + WS_BIG), (const bf16*)(ws + WS_DN), M_, 2048, FF_}; const pg8::EpiResid E{args.in[0], nullptr, nullptr, (bf16*)(ws + WS_H), (float*)(ws + WS_SSQ1), 2048, 0.5f}; GEMM(pg8::EpiResid, g, E, 0); }
        SEAM(2);
    }
    if (IN(4)) {
        __syncthreads();
        { const pg8::Gemm g{(const bf16*)(ws + WS_H), (const bf16*)(ws + WS_WIN), M_, NWIN, 2048};
          const pg8::EpiWin E{(bf16*)(ws + WS_UP), (bf16*)(ws + WS_QF), (bf16*)(ws + WS_KF), (bf16*)(ws + WS_VF), (bf16*)(ws + WS_QM), (bf16*)(ws + WS_GATE), (float*)(ws + WS_LOGF), args.in[8], (const float*)(ws + WS_SSQ1), args.in[12], args.in[13], args.in[16], (LAS float*)(L + RING_BYTES)};
          GEMM(pg8::EpiWin, g, E, 0); }
        { const pg8::Gemm g{(const bf16*)(ws + WS_MEMN), (const bf16*)(ws + WS_WMKV), MM_, 512, 2048}; const pg8::EpiBf16<0> E{(bf16*)(ws + WS_KM), 512, nullptr, 0, 0, 1.f}; GEMM(pg8::EpiBf16<0>, g, E, G / 2); }
        { const pg8::Gemm g{(const bf16*)(ws + WS_WMKV) + (size_t)512 * 2048, (const bf16*)(ws + WS_MEMN), 512, MM_, 2048}; const pg8::EpiBf16<0> E{(bf16*)(ws + WS_VT), MM_, nullptr, 0, 0, 1.f}; GEMM(pg8::EpiBf16<0>, g, E, (3 * G) / 8); }
        if (bx >= (3 * G) / 4) { const int gw2 = (bx - (3 * G) / 4) * NWAVES + wave, NGW2 = (G - (3 * G) / 4) * NWAVES;
          const int i0 = transpose_items(2048, 11264), i1 = transpose_items(5632, 2048);
          for (int it = gw2; it < i0 + i1; it += NGW2) {
            if (it < i0) transpose_item(args.in[21], 2048, 11264, (bf16*)(ws + WS_GU), 1, scr, it, lane, 0, 0, args.in[20]);
            else transpose_item(args.in[22], 5632, 2048, (bf16*)(ws + WS_DN), 0, scr, it - i0, lane); } }
        SEAM(4);
    }
    if (IN(6)) {
        { const bf16* UP = (const bf16*)(ws + WS_UP); bf16* PD = (bf16*)args.out;
          for (int it = gtid; it < (M_ / 8) * 64; it += NT) { const int cc = it & 63, m0 = (it >> 6) * 8, t0 = m0 & (S_ - 1), w = 2 << (cc >> 4);
            const bf16* up = UP + (size_t)m0 * 512 + cc * 8;
            v4u hv[15], cv[8];
#pragma unroll
            for (int j = 0; j < 15; ++j) { hv[j] = (v4u){0u, 0u, 0u, 0u}; if (j + 1 < w && t0 >= j + 1) hv[j] = *(const v4u*)(up - (size_t)(j + 1) * 512); }
#pragma unroll
            for (int r = 0; r < 8; ++r) cv[r] = *(const v4u*)(up + (size_t)r * 512);
#pragma unroll
            for (int r = 0; r < 8; ++r) { float s0 = 0.f, s1 = 0.f, s2 = 0.f, s3 = 0.f, s4 = 0.f, s5 = 0.f, s6 = 0.f, s7 = 0.f;
#pragma unroll
                for (int j = 0; j < 16; ++j) { if (j <= r + 15) { const v4u v = (r - j >= 0) ? cv[(r - j >= 0) ? r - j : 0] : hv[(j - r - 1 >= 0 && j - r - 1 < 15) ? j - r - 1 : 0];
                    if (j < w) { s0 += pg8::bf_lo(v.x); s1 += pg8::bf_hi(v.x); s2 += pg8::bf_lo(v.y); s3 += pg8::bf_hi(v.y); s4 += pg8::bf_lo(v.z); s5 += pg8::bf_hi(v.z); s6 += pg8::bf_lo(v.w); s7 += pg8::bf_hi(v.w); } } }
                const int tt = t0 + r + 1; const float rn = 1.0f / (float)(tt < w ? tt : w); const v4u c = cv[r];
                v4u o; o.x = pk2(s0 * rn - pg8::bf_lo(c.x), s1 * rn - pg8::bf_hi(c.x)); o.y = pk2(s2 * rn - pg8::bf_lo(c.y), s3 * rn - pg8::bf_hi(c.y));
                o.z = pk2(s4 * rn - pg8::bf_lo(c.z), s5 * rn - pg8::bf_hi(c.z)); o.w = pk2(s6 * rn - pg8::bf_lo(c.w), s7 * rn - pg8::bf_hi(c.w));
                *(v4u*)(PD + (size_t)(m0 + r) * 2048 + cc * 8) = o; } } }
        __syncthreads();
        { const attn_body::AttnTensors AT{(const attn_body::bf16*)(ws + WS_QF), (const attn_body::bf16*)(ws + WS_KF), (const attn_body::bf16*)(ws + WS_VF), (attn_body::bf16*)args.out + 512, (const float*)(ws + WS_LOGF)};
          const attn_body::StaticOrder S(G, vcu);
          attn_body::attn_phase<attn_body::StaticOrder, 40>((char*)lds, AT, S); }
        __syncthreads();
        for (int p = vcu; p < B_ * 4 * 4; p += G) { const int b = p >> 4, hm = (p >> 2) & 3;
            memattn::stage_kv(b, hm, (const bf16*)(ws + WS_KM), (const bf16*)(ws + WS_VT), args.in[17], L);
            __syncthreads();
            memattn::unit(b, hm, (p & 3) * 2, (const bf16*)(ws + WS_QM), (bf16*)args.out + 1536, L);
            memattn::unit(b, hm, (p & 3) * 2 + 1, (const bf16*)(ws + WS_QM), (bf16*)args.out + 1536, L);
            __syncthreads(); }
        SEAM(6);
    }
    if (IN(7)) {
        __syncthreads();
        { const pg8::Gemm g{(const bf16*)args.out, (const bf16*)(ws + WS_WCAT), M_, 2048, 2048}; const pg8::EpiGate E{(bf16*)(ws + WS_QF), (const bf16*)(ws + WS_GATE)}; GEMM(pg8::EpiGate, g, E, 0); }
        SEAM(7);
    }
    if (IN(8)) {
        __syncthreads();
        { const pg8::Gemm g{(const bf16*)(ws + WS_QF), (const bf16*)(ws + WS_WO), M_, 2048, 2048}; const pg8::EpiResid E{nullptr, (const bf16*)(ws + WS_H), nullptr, (bf16*)(ws + WS_H3), (float*)(ws + WS_SSQ2), 2048, 1.0f}; GEMM(pg8::EpiResid, g, E, 0); }
        SEAM(8);
    }
    if (IN(10)) {
        __syncthreads();
        { const pg8::Gemm g{(const bf16*)(ws + WS_H3), (const bf16*)(ws + WS_GU), M_, 2 * FF_, 2048}; const pg8::EpiSwiGLU E{(bf16*)(ws + WS_BIG), FF_, (const float*)(ws + WS_SSQ2)}; GEMM(pg8::EpiSwiGLU, g, E, 0); }
        SEAM(10);
    }
    if (IN(11)) {
        __syncthreads();
        { const pg8::Gemm g{(const bf16*)(ws + WS_BIG), (const bf16*)(ws + WS_DN), M_, 2048, FF_}; const pg8::EpiResid E{nullptr, (const bf16*)(ws + WS_H3), args.out, nullptr, nullptr, 2048, 0.5f}; GEMM(pg8::EpiResid, g, E, 0); }
    }
    if (hi > 4096) cg::this_grid().sync();
#undef IN
#undef SEAM
#undef GEMM
}

extern "C" void kernel_launch(void* const* d_in, const int* in_sizes, int n_in, void* d_out, int out_size, void* d_ws, size_t ws_size, hipStream_t stream) {
    static int grid = 0;
    if (grid == 0) {
        if (n_in != 23 || in_sizes[0] != M_ * DM_ || out_size != M_ * DM_ || ws_size < WS_END) { fprintf(stderr, "kernel_launch: unexpected problem (n_in %d, ws %zu < %zu?); nothing launched\n", n_in, ws_size, (size_t)WS_END); grid = -1; return; }
        int dev = 0, cus = 0, per_cu = 0;
        if (hipGetDevice(&dev) != hipSuccess || hipDeviceGetAttribute(&cus, hipDeviceAttributeMultiprocessorCount, dev) != hipSuccess) { grid = -1; return; }
        if (hipFuncSetAttribute((const void*)mk_fwd, hipFuncAttributeMaxDynamicSharedMemorySize, LDS_BYTES) != hipSuccess) { fprintf(stderr, "kernel_launch: hipFuncSetAttribute failed\n"); grid = -1; return; }
        if (hipOccupancyMaxActiveBlocksPerMultiprocessor(&per_cu, (const void*)mk_fwd, NWAVES * 64, LDS_BYTES) != hipSuccess || per_cu < 1) { fprintf(stderr, "kernel_launch: occupancy query says %d\n", per_cu); per_cu = 1; }
        (void)hipGetLastError();
        grid = cus * per_cu;
    }
    if (grid < 0) return;
    (void)hipMemsetAsync((unsigned char*)d_ws + WS_BAR, 0, WS_BAR_BYTES, stream);
    Args a{};
    for (int i = 0; i < 23; ++i) a.in[i] = (const float*)d_in[i];
    a.out = (float*)d_out; a.ws = (unsigned char*)d_ws;
#if MK_N_LAUNCHES == 1
    a.ph_lo = 0; a.ph_hi = NPH;
    void* kargs[] = {&a};
    hipError_t e = hipLaunchCooperativeKernel((const void*)mk_fwd, dim3(grid), dim3(NWAVES * 64), kargs, LDS_BYTES, stream);
    if (e != hipSuccess) fprintf(stderr, "kernel_launch: cooperative launch failed: %s (grid %d)\n", hipGetErrorString(e), grid);
#elif MK_N_LAUNCHES == 112
    for (int ph = 0; ph < NPH; ++ph) { a.ph_lo = ph; a.ph_hi = ph + 1; void* kargs[] = {&a}; (void)hipLaunchCooperativeKernel((const void*)mk_fwd, dim3(grid), dim3(NWAVES * 64), kargs, LDS_BYTES, stream); }
#else
    for (int ph = 0; ph < NPH; ++ph) { a.ph_lo = ph; a.ph_hi = ph + 1; for (int rep = 0; rep < (((PROBE_DOUBLE_MASK) >> ph) & 1) + 1; ++rep) hipLaunchKernelGGL(mk_fwd, dim3(grid), dim3(NWAVES * 64), LDS_BYTES, stream, a); }
#endif
}
```

```cpp
#define MK_N_LAUNCHES 1
#include <hip/hip_runtime.h>
#include <hip/hip_cooperative_groups.h>
namespace cg = cooperative_groups;
#include <hip/hip_runtime.h>
#include <cstdio>
#include <cstdint>
namespace pg8 {
#define PG8_LAS __attribute__((address_space(3)))
typedef unsigned short bf16_t;
typedef short bf16x8 __attribute__((ext_vector_type(8)));
typedef float f32x4 __attribute__((ext_vector_type(4)));
typedef unsigned u32x4 __attribute__((ext_vector_type(4)));
constexpr int BM = 256, BK = 64, HALF = 128, HTB = HALF * BK * 2  , STAGE_BYTES = 8 * HTB, NXCD = 8, WGM = 8;

__host__ __device__ __forceinline__ int lds_byte(int r, int c) { const int st = (r >> 4) * 2 + (c >> 5), rr = r & 15, cc = c & 31, ob = rr * 64 + cc * 2; return st * 1024 + (ob ^ (((ob >> 9) & 1) << 5)); }
__host__ __device__ __forceinline__ void stage_rc(int b, int& R, int& C) { const int st = b / 1024, sb = b % 1024, swz = sb ^ (((sb >> 9) & 1) << 5); R = (st >> 1) * 16 + swz / 64; C = (st & 1) * 32 + (swz % 64) / 2; }
__host__ __device__ __forceinline__ int perm32(int rho) { const int n = rho >> 4, i = rho & 15; return 8 * (i >> 2) + 4 * n + (i & 3); }

struct Unit { int pm, pn; };
struct Gemm { const bf16_t* A; const bf16_t* Bt; int M, N, K; };

struct StaticOrder {
    int nM, nN, nwg, G, c;
    __host__ __device__ void init(int M, int N, int G_, int c_) { nM = M / BM; nN = N / BM; nwg = nM * nN; G = G_; c = c_; }
    __host__ __device__ bool next(int i, Unit& u) const {
        const long L = (long)i * G + c; if (L >= nwg) return false;
        int wgid = (int)L; { const int q = nwg / NXCD, r = nwg % NXCD, xcd = wgid % NXCD, off = wgid / NXCD; wgid = (xcd < r ? xcd * (q + 1) : r * (q + 1) + (xcd - r) * q) + off; }
        const int nig = WGM * nN, gid = wgid / nig, fm = gid * WGM, gsz = (nM - fm) < WGM ? (nM - fm) : WGM;
        u.pm = fm + ((wgid % nig) % gsz); u.pn = (wgid % nig) / gsz; return true;
    }
    __device__ __forceinline__ void a_ready(const Unit&) const {}
    __device__ __forceinline__ void done(const Unit&) const {}
};

__device__ __forceinline__ unsigned cvt_pk_bf16(float lo, float hi) { unsigned r; asm volatile("v_cvt_pk_bf16_f32 %0, %1, %2" : "=v"(r) : "v"(lo), "v"(hi)); return r; }
typedef float f32x2 __attribute__((ext_vector_type(2)));
__device__ __forceinline__ f32x2 gelu_pk(f32x2 v) {
    const f32x2 av = __builtin_elementwise_abs(v), d = av * 0.2316418882f + 1.0f;
    f32x2 t; t.x = __builtin_amdgcn_rcpf(d.x); t.y = __builtin_amdgcn_rcpf(d.y);
    f32x2 q = t * 0.5307027145f + (-0.7265760135f); q = q * t + 0.7107068705f; q = q * t + (-0.142248368f); q = q * t + 0.127414796f; q = q * t;
    const f32x2 s = (v * v) * (-0.72134752044f);
    f32x2 e; e.x = __builtin_amdgcn_exp2f(s.x); e.y = __builtin_amdgcn_exp2f(s.y);
    const f32x2 m = v * (q * e), r = v - m;
    f32x2 o; o.x = v.x < 0.f ? m.x : r.x; o.y = v.y < 0.f ? m.y : r.y; return o;
}

template <int ACT  > struct EpiBf16 {
    static constexpr bool PERM = true, AFTER_DRAIN = false, HOOK = false; static constexpr int H1 = -1, H2 = -1; static_assert(ACT == 0 || ACT == 1, "EpiBf16: ACT is 0 (none) or 1 (gelu_pk)");
    bf16_t* O; int ldc; const float* bias; int split_cols; size_t split_stride; float scale0;
    __device__ __forceinline__ void operator()(const f32x4 (&acc)[2][2][4][2], const Unit& u, int wr, int wc, int fr, int fq) const {
        const int row0 = u.pm * BM + wr * 64 + fr; int colt = u.pn * BM; bf16_t* base = O;
        float sc = 1.f; if (split_cols) { const int t = colt / split_cols; base += (size_t)t * split_stride; colt -= t * split_cols; if (t == 0) sc = scale0; }
        const int col0 = colt + wc * 32 + 8 * fq, bcol0 = u.pn * BM + wc * 32 + 8 * fq;
        f32x4 bv[2][2];
#pragma unroll
        for (int bj = 0; bj < 2; ++bj)
#pragma unroll
            for (int n = 0; n < 2; ++n) bv[bj][n] = bias ? *(const f32x4*)(bias + bcol0 + bj * HALF + 4 * n) : (f32x4){0.f, 0.f, 0.f, 0.f};
#pragma unroll
        for (int ai = 0; ai < 2; ++ai)
#pragma unroll
            for (int m = 0; m < 4; ++m) { bf16_t* rowp = base + (size_t)(row0 + ai * HALF + m * 16) * ldc + col0;
#pragma unroll
                for (int bj = 0; bj < 2; ++bj) { f32x4 v0 = acc[ai][bj][m][0] + bv[bj][0], v1 = acc[ai][bj][m][1] + bv[bj][1];
                    if (ACT == 1) { f32x2 a = gelu_pk((f32x2){v0[0], v0[1]}), b = gelu_pk((f32x2){v0[2], v0[3]}), c = gelu_pk((f32x2){v1[0], v1[1]}), d = gelu_pk((f32x2){v1[2], v1[3]});
                        v0 = (f32x4){a.x, a.y, b.x, b.y}; v1 = (f32x4){c.x, c.y, d.x, d.y}; }
                    v0 = v0 * sc; v1 = v1 * sc; u32x4 w; w.x = cvt_pk_bf16(v0[0], v0[1]); w.y = cvt_pk_bf16(v0[2], v0[3]); w.z = cvt_pk_bf16(v1[0], v1[1]); w.w = cvt_pk_bf16(v1[2], v1[3]);
                    *(u32x4*)(rowp + bj * HALF) = w; } }
    }
};
__device__ __forceinline__ float sigm_f(float g) { return __builtin_amdgcn_rcpf(1.0f + __builtin_amdgcn_exp2f(-1.4426950408889634f * g)); }
__device__ __forceinline__ float silu_f(float g) { return g * sigm_f(g); }
__device__ __forceinline__ float sigm2_f(float x) { return __builtin_amdgcn_rcpf(1.0f + __builtin_amdgcn_exp2f(-x)); }
__device__ __forceinline__ float gate_f(float x) { return fmaxf(sigm2_f(x), 1e-18f); }
__device__ __forceinline__ float bf_lo(unsigned w) { return __uint_as_float(w << 16); }
__device__ __forceinline__ float bf_hi(unsigned w) { return __uint_as_float(w & 0xffff0000u); }
__device__ __forceinline__ float logsig_f(float x) { return fminf(x, 0.f) - 0.6931471805599453f * __builtin_amdgcn_logf(1.0f + __builtin_amdgcn_exp2f(-1.4426950408889634f * fabsf(x))); }

struct EpiSwiGLU {
    static constexpr bool PERM = true, AFTER_DRAIN = false, HOOK = false; static constexpr int H1 = -1, H2 = -1;
    bf16_t* O; int ldc; const float* ssq;
    __device__ __forceinline__ void operator()(const f32x4 (&acc)[2][2][4][2], const Unit& u, int wr, int wc, int fr, int fq) const {
        const int row0 = u.pm * BM + wr * 64 + fr, col0 = u.pn * HALF + wc * 32 + 8 * fq;
#pragma unroll
        for (int ai = 0; ai < 2; ++ai)
#pragma unroll
            for (int m = 0; m < 4; ++m) { bf16_t* p = O + (size_t)(row0 + ai * HALF + m * 16) * ldc + col0;
                const float rs = ssq ? 1.0f / sqrtf(ssq[row0 + ai * HALF + m * 16] * (1.0f / 2048.0f) + 1e-6f) : 1.0f;
                const f32x4 g0 = acc[ai][0][m][0] * rs, g1 = acc[ai][0][m][1] * rs, u0 = acc[ai][1][m][0] * rs, u1 = acc[ai][1][m][1] * rs;
                u32x4 w; w.x = cvt_pk_bf16(g0[0] * sigm2_f(g0[0]) * u0[0], g0[1] * sigm2_f(g0[1]) * u0[1]); w.y = cvt_pk_bf16(g0[2] * sigm2_f(g0[2]) * u0[2], g0[3] * sigm2_f(g0[3]) * u0[3]);
                w.z = cvt_pk_bf16(g1[0] * sigm2_f(g1[0]) * u1[0], g1[1] * sigm2_f(g1[1]) * u1[1]); w.w = cvt_pk_bf16(g1[2] * sigm2_f(g1[2]) * u1[2], g1[3] * sigm2_f(g1[3]) * u1[3]);
                *(u32x4*)p = w; }
    }
};
struct EpiResid {
    static constexpr bool PERM = true, AFTER_DRAIN = false, HOOK = false; static constexpr int H1 = -1, H2 = -1;
    const float* basef; const bf16_t* baseb; float* outf; bf16_t* outb; float* ssq; int ldc; float alpha;
    __device__ __forceinline__ void operator()(const f32x4 (&acc)[2][2][4][2], const Unit& u, int wr, int wc, int fr, int fq) const {
        const int col0 = u.pn * BM + wc * 32 + 8 * fq;
#pragma unroll
        for (int ai = 0; ai < 2; ++ai) {
            f32x4 bf0[4][2], bf1[4][2]; u32x4 bq[4][2]; float keep = 0.f;
#pragma unroll
            for (int m = 0; m < 4; ++m)
#pragma unroll
                for (int bj = 0; bj < 2; ++bj) { const size_t idx = (size_t)(u.pm * BM + ai * HALF + wr * 64 + m * 16 + fr) * ldc + col0 + bj * HALF;
                    if (basef) { bf0[m][bj] = *(const f32x4*)(basef + idx); bf1[m][bj] = *(const f32x4*)(basef + idx + 4); } else bq[m][bj] = *(const u32x4*)(baseb + idx); }
#pragma unroll
            for (int m = 0; m < 4; ++m) { const int row = u.pm * BM + ai * HALF + wr * 64 + m * 16 + fr; const size_t off = (size_t)row * ldc + col0; float ss = 0.f;
#pragma unroll
                for (int bj = 0; bj < 2; ++bj) { const size_t idx = off + bj * HALF; f32x4 b0, b1;
                    if (basef) { b0 = bf0[m][bj]; b1 = bf1[m][bj]; }
                    else { const u32x4 q = bq[m][bj]; b0 = (f32x4){bf_lo(q.x), bf_hi(q.x), bf_lo(q.y), bf_hi(q.y)}; b1 = (f32x4){bf_lo(q.z), bf_hi(q.z), bf_lo(q.w), bf_hi(q.w)}; }
                    const f32x4 v0 = b0 + acc[ai][bj][m][0] * alpha, v1 = b1 + acc[ai][bj][m][1] * alpha;
                    if (outf) { *(f32x4*)(outf + idx) = v0; *(f32x4*)(outf + idx + 4) = v1; }
                    if (outb) { u32x4 w; w.x = cvt_pk_bf16(v0[0], v0[1]); w.y = cvt_pk_bf16(v0[2], v0[3]); w.z = cvt_pk_bf16(v1[0], v1[1]); w.w = cvt_pk_bf16(v1[2], v1[3]); *(u32x4*)(outb + idx) = w; }
                    ss += ((v0[0] * v0[0] + v0[1] * v0[1]) + (v0[2] * v0[2] + v0[3] * v0[3])) + ((v1[0] * v1[0] + v1[1] * v1[1]) + (v1[2] * v1[2] + v1[3] * v1[3])); }
                if (ssq) { ss += __shfl_xor(ss, 16); ss += __shfl_xor(ss, 32); if (m == fq) keep = ss; } }
            if (ssq) (void)__hip_atomic_fetch_add(ssq + (u.pm * BM + ai * HALF + wr * 64 + fq * 16 + fr), keep, __ATOMIC_RELAXED, __HIP_MEMORY_SCOPE_AGENT); }
    }
};
struct EpiWin {
    static constexpr bool PERM = true, AFTER_DRAIN = false, HOOK = false; static constexpr int H1 = -1, H2 = -1;
    bf16_t *UP, *QF, *KF, *VF, *QM, *GATE; float* LOGF; const float* bfg; const float* ssq; const float *gq, *gk, *gm; PG8_LAS float* X;
    __device__ __forceinline__ void operator()(const f32x4 (&acc)[2][2][4][2], const Unit& u, int wr, int wc, int fr, int fq) const {
        const int pn = u.pn, row0 = u.pm * BM + wr * 64 + fr;
        if (pn == 40) {
            if (wc == 0 && fq < 2) {
                const f32x4 b0 = *(const f32x4*)(bfg + 8 * fq), b1 = *(const f32x4*)(bfg + 8 * fq + 4);
#pragma unroll
                for (int ai = 0; ai < 2; ++ai)
#pragma unroll
                    for (int m = 0; m < 4; ++m) { float* p = LOGF + (size_t)(row0 + ai * HALF + m * 16) * 16 + 8 * fq;
                        const float rs = 1.0f / sqrtf(ssq[row0 + ai * HALF + m * 16] * (1.0f / 2048.0f) + 1e-6f);
                        const f32x4 v0 = acc[ai][0][m][0] * rs + b0, v1 = acc[ai][0][m][1] * rs + b1;
                        *(f32x4*)p = (f32x4){logsig_f(v0[0]), logsig_f(v0[1]), logsig_f(v0[2]), logsig_f(v0[3])};
                        *(f32x4*)(p + 4) = (f32x4){logsig_f(v1[0]), logsig_f(v1[1]), logsig_f(v1[2]), logsig_f(v1[3])}; }
            }
            return;
        }
        bf16_t* O; int ldc, colt; bool sg = false; int hn = 0; const float* gain = nullptr; float hscale = 1.f;
        if (pn < 2) { O = UP; ldc = 512; colt = pn * BM; } else if (pn < 6) { O = QF; ldc = 1024; colt = (pn - 2) * BM; hn = 1; gain = gq; hscale = 0.125f * 1.4426950408889634f; }
        else if (pn < 10) { O = KF; ldc = 1024; colt = (pn - 6) * BM; hn = 1; gain = gk; }
        else if (pn < 14) { O = VF; ldc = 1024; colt = (pn - 10) * BM; } else if (pn < 16) { O = QM; ldc = 512; colt = (pn - 14) * BM; hn = 2; gain = gm; hscale = 0.08838834764831845f * 1.4426950408889634f; }
        else { O = GATE; ldc = 6144; colt = (pn - 16) * BM; sg = true; }
        const int col0 = colt + wc * 32 + 8 * fq;
        float rsv[2][4];
#pragma unroll
        for (int ai = 0; ai < 2; ++ai)
#pragma unroll
            for (int m = 0; m < 4; ++m) rsv[ai][m] = 1.0f / sqrtf(ssq[row0 + ai * HALF + m * 16] * (1.0f / 2048.0f) + 1e-6f);
        if (hn) {
#pragma unroll
            for (int ai = 0; ai < 2; ++ai)
#pragma unroll
                for (int m = 0; m < 4; ++m) { const int rowl = ai * HALF + wr * 64 + m * 16 + fr; const float rs = rsv[ai][m];
#pragma unroll
                    for (int bj = 0; bj < 2; ++bj) { const f32x4 v0 = acc[ai][bj][m][0] * rs, v1 = acc[ai][bj][m][1] * rs;
                        float s = (v0[0] * v0[0] + v0[1] * v0[1]) + (v0[2] * v0[2] + v0[3] * v0[3]) + (v1[0] * v1[0] + v1[1] * v1[1]) + (v1[2] * v1[2] + v1[3] * v1[3]);
                        s += __shfl_xor(s, 16); s += __shfl_xor(s, 32);
                        if (fq == 0) X[(rowl * 2 + bj) * 4 + wc] = s; } }
            asm volatile("s_waitcnt lgkmcnt(0)" ::: "memory"); __builtin_amdgcn_s_barrier(); asm volatile("" ::: "memory");
            const int d0 = (hn == 1 ? 32 * (wc & 1) : 32 * wc) + 8 * fq; const f32x4 g0 = *(const f32x4*)(gain + d0), g1 = *(const f32x4*)(gain + d0 + 4);
            const float ihd = hn == 1 ? (1.0f / 64.0f) : (1.0f / 128.0f);
#pragma unroll
            for (int ai = 0; ai < 2; ++ai)
#pragma unroll
                for (int m = 0; m < 4; ++m) { const int rowl = ai * HALF + wr * 64 + m * 16 + fr; bf16_t* rowp = O + (size_t)(row0 + ai * HALF + m * 16) * ldc + col0;
#pragma unroll
                    for (int bj = 0; bj < 2; ++bj) { const f32x4 xs = *(const PG8_LAS f32x4*)(X + (rowl * 2 + bj) * 4);
                        const float tot = hn == 1 ? ((wc & 2) ? xs[2] + xs[3] : xs[0] + xs[1]) : (xs[0] + xs[1]) + (xs[2] + xs[3]);
                        const float r = rsv[ai][m] * hscale / sqrtf(tot * ihd + 1e-6f);
                        const f32x4 v0 = acc[ai][bj][m][0] * r * g0, v1 = acc[ai][bj][m][1] * r * g1;
                        u32x4 w; w.x = cvt_pk_bf16(v0[0], v0[1]); w.y = cvt_pk_bf16(v0[2], v0[3]); w.z = cvt_pk_bf16(v1[0], v1[1]); w.w = cvt_pk_bf16(v1[2], v1[3]);
                        *(u32x4*)(rowp + bj * HALF) = w; } }
            return;
        }
#pragma unroll
        for (int ai = 0; ai < 2; ++ai)
#pragma unroll
            for (int m = 0; m < 4; ++m) { bf16_t* rowp = O + (size_t)(row0 + ai * HALF + m * 16) * ldc + col0; const float rs = rsv[ai][m];
#pragma unroll
                for (int bj = 0; bj < 2; ++bj) { f32x4 v0 = acc[ai][bj][m][0] * rs, v1 = acc[ai][bj][m][1] * rs;
                    if (sg) { v0 = (f32x4){gate_f(v0[0]), gate_f(v0[1]), gate_f(v0[2]), gate_f(v0[3])}; v1 = (f32x4){gate_f(v1[0]), gate_f(v1[1]), gate_f(v1[2]), gate_f(v1[3])}; }
                    u32x4 w; w.x = cvt_pk_bf16(v0[0], v0[1]); w.y = cvt_pk_bf16(v0[2], v0[3]); w.z = cvt_pk_bf16(v1[0], v1[1]); w.w = cvt_pk_bf16(v1[2], v1[3]);
                    *(u32x4*)(rowp + bj * HALF) = w; } }
    }
};
struct EpiGate {
    static constexpr bool PERM = true, AFTER_DRAIN = false, HOOK = true; static constexpr int H1 = 8, H2 = 24;
    bf16_t* MG; const bf16_t* G;
    __device__ __forceinline__ void hook(f32x4 (&acc)[2][2][4][2], const Unit& u, int t, int wr, int wc, int fr, int fq) const {
        asm volatile("" : "+v"(fr), "+v"(fq));
        const int row0 = u.pm * BM + wr * 64 + fr, col0 = u.pn * BM + wc * 32 + 8 * fq, gnum = (t == H1) ? 0 : 2048;
#pragma unroll
        for (int ai = 0; ai < 2; ++ai) {
            u32x4 ga[4][2], gb[4][2];
            asm volatile("" ::: "memory");
#pragma unroll
            for (int m = 0; m < 4; ++m) { const bf16_t* gp = G + (size_t)(row0 + ai * HALF + m * 16) * 6144 + gnum + col0;
#pragma unroll
                for (int bj = 0; bj < 2; ++bj) { ga[m][bj] = *(const u32x4*)(gp + bj * HALF); gb[m][bj] = *(const u32x4*)(gp + 2048 + bj * HALF); } }
#pragma unroll
            for (int m = 0; m < 4; ++m)
#pragma unroll
                for (int bj = 0; bj < 2; ++bj) { const u32x4 a = ga[m][bj], b = gb[m][bj];
                    const f32x4 r0 = (f32x4){bf_lo(a.x) * __builtin_amdgcn_rcpf(bf_lo(b.x)), bf_hi(a.x) * __builtin_amdgcn_rcpf(bf_hi(b.x)), bf_lo(a.y) * __builtin_amdgcn_rcpf(bf_lo(b.y)), bf_hi(a.y) * __builtin_amdgcn_rcpf(bf_hi(b.y))};
                    const f32x4 r1 = (f32x4){bf_lo(a.z) * __builtin_amdgcn_rcpf(bf_lo(b.z)), bf_hi(a.z) * __builtin_amdgcn_rcpf(bf_hi(b.z)), bf_lo(a.w) * __builtin_amdgcn_rcpf(bf_lo(b.w)), bf_hi(a.w) * __builtin_amdgcn_rcpf(bf_hi(b.w))};
                    acc[ai][bj][m][0] *= r0; acc[ai][bj][m][1] *= r1; }
            asm volatile("" ::: "memory"); }
        asm volatile("s_waitcnt vmcnt(0)" ::: "memory");
    }
    __device__ __forceinline__ void operator()(const f32x4 (&acc)[2][2][4][2], const Unit& u, int wr, int wc, int fr, int fq) const {
        const int row0 = u.pm * BM + wr * 64 + fr, col0 = u.pn * BM + wc * 32 + 8 * fq;
#pragma unroll
        for (int ai = 0; ai < 2; ++ai) {
            u32x4 gq[4][2];
#pragma unroll
            for (int m = 0; m < 4; ++m)
#pragma unroll
                for (int bj = 0; bj < 2; ++bj) gq[m][bj] = *(const u32x4*)(G + (size_t)(row0 + ai * HALF + m * 16) * 6144 + 4096 + col0 + bj * HALF);
#pragma unroll
            for (int m = 0; m < 4; ++m) { const size_t row = (size_t)(row0 + ai * HALF + m * 16);
#pragma unroll
                for (int bj = 0; bj < 2; ++bj) { const int col = col0 + bj * HALF; const u32x4 gv = gq[m][bj];
                    const f32x4 a0 = acc[ai][bj][m][0], a1 = acc[ai][bj][m][1];
                    u32x4 w; w.x = cvt_pk_bf16(bf_lo(gv.x) * a0[0], bf_hi(gv.x) * a0[1]); w.y = cvt_pk_bf16(bf_lo(gv.y) * a0[2], bf_hi(gv.y) * a0[3]);
                    w.z = cvt_pk_bf16(bf_lo(gv.z) * a1[0], bf_hi(gv.z) * a1[1]); w.w = cvt_pk_bf16(bf_lo(gv.w) * a1[2], bf_hi(gv.w) * a1[3]);
                    *(u32x4*)(MG + row * 2048 + col) = w; } } }
    }
};
template <class Epi, class Sched, bool ALIGN_EPI = false, bool SP2 = false>
__device__ __forceinline__ void gemm_phase(PG8_LAS unsigned char* lds, const Gemm g, const Sched& S, const Epi& E) {
    const int tid = threadIdx.x, wid = __builtin_amdgcn_readfirstlane(tid >> 6), lane = tid & 63, wr = wid >> 2, wc = wid & 3, fr = lane & 15, fq = lane >> 4;
    const int K = g.K, nt = K / BK;
    unsigned voffA[2], voffB[2];
#pragma unroll
    for (int i = 0; i < 2; ++i) { int R, C; stage_rc(tid * 16 + i * 8192, R, C); const int Rb = Epi::PERM ? ((R & ~31) + perm32(R & 31)) : R;
        voffA[i] = (unsigned)(R * K + C) * 2u; voffB[i] = (unsigned)(Rb * K + C) * 2u; }
    const size_t kstep = (size_t)(BK * 2);
    const size_t hstep = (size_t)HALF * K * 2;
    const size_t tstep = 2 * hstep;
    const unsigned ldsw = (unsigned)wid * 1024u;
    const int aoff = lds_byte(wr * 64 + fr, fq * 8), boff = lds_byte(wc * 32 + fr, fq * 8);
#define PG8_SA(b, h) (((b) * 2 + (h)) * HTB)
#define PG8_SB(b, h) ((4 + (b) * 2 + (h)) * HTB)
#define PG8_STAGE(bufoff, gbase, voff) do { _Pragma("unroll") for (int _i = 0; _i < 2; ++_i) \
        __builtin_amdgcn_global_load_lds((const unsigned*)((const char*)(gbase) + (voff)[_i]), (PG8_LAS unsigned*)(lds + (bufoff) + ldsw + _i * 8192), 16, 0, 0); } while (0)
#define PG8_LDA(dst, b, h) do { _Pragma("unroll") for (int m = 0; m < 4; ++m) _Pragma("unroll") for (int k = 0; k < 2; ++k) dst[m][k] = *(const PG8_LAS bf16x8*)(lds + PG8_SA(b, h) + aoff + m * 2048 + k * 1024); } while (0)
#define PG8_LDB(dst, b, h) do { _Pragma("unroll") for (int n = 0; n < 2; ++n) _Pragma("unroll") for (int k = 0; k < 2; ++k) dst[n][k] = *(const PG8_LAS bf16x8*)(lds + PG8_SB(b, h) + boff + n * 2048 + k * 1024); } while (0)
#define PG8_MMA(ai, bj, At, Bt) do { __builtin_amdgcn_s_setprio(1); _Pragma("unroll") for (int m = 0; m < 4; ++m) _Pragma("unroll") for (int n = 0; n < 2; ++n) _Pragma("unroll") for (int k = 0; k < 2; ++k) \
        acc[ai][bj][m][n] = __builtin_amdgcn_mfma_f32_16x16x32_bf16(Bt[n][k], At[m][k], acc[ai][bj][m][n], 0, 0, 0); __builtin_amdgcn_s_setprio(0); } while (0)
#define PG8_WAIT_V(n) asm volatile("s_waitcnt vmcnt(" #n ")" ::: "memory")
#define PG8_WAIT_L(n) asm volatile("s_waitcnt lgkmcnt(" #n ")" ::: "memory")
#define PG8_BAR __builtin_amdgcn_s_barrier()
#define PG8_SCHED __builtin_amdgcn_sched_barrier(0)
    Unit cur, nxt; int ui = 0;
    if (!S.next(0, cur)) return;
    f32x4 acc[2][2][4][2];
#pragma unroll
    for (int a = 0; a < 2; ++a)
#pragma unroll
        for (int b = 0; b < 2; ++b)
#pragma unroll
            for (int m = 0; m < 4; ++m)
#pragma unroll
                for (int n = 0; n < 2; ++n) acc[a][b][m][n] = (f32x4){0.f, 0.f, 0.f, 0.f};
    bf16x8 At[4][2], B0[2][2], B1[2][2];
    const char* cA = (const char*)g.A + (size_t)cur.pm * tstep; const char* cB = (const char*)g.Bt + (size_t)cur.pn * tstep;
    S.a_ready(cur);
    if constexpr (SP2) {
        PG8_STAGE(PG8_SB(0, 0), cB, voffB); PG8_STAGE(PG8_SB(0, 1), cB + hstep, voffB); PG8_STAGE(PG8_SA(0, 0), cA, voffA); PG8_STAGE(PG8_SA(0, 1), cA + hstep, voffA);
        if (wr == 1) PG8_BAR;
        PG8_WAIT_V(2); PG8_BAR;
        PG8_STAGE(PG8_SB(1, 0), cB + kstep, voffB); PG8_STAGE(PG8_SA(1, 0), cA + kstep, voffA); PG8_STAGE(PG8_SB(1, 1), cB + hstep + kstep, voffB);
        PG8_WAIT_V(6); PG8_BAR;
    } else {
        PG8_STAGE(PG8_SB(0, 0), cB, voffB); PG8_STAGE(PG8_SA(0, 0), cA, voffA); PG8_STAGE(PG8_SB(0, 1), cB + hstep, voffB); PG8_STAGE(PG8_SA(0, 1), cA + hstep, voffA);
        if (wr == 1) PG8_BAR;
        PG8_WAIT_V(4); PG8_BAR;
        PG8_STAGE(PG8_SB(1, 0), cB + kstep, voffB); PG8_STAGE(PG8_SA(1, 0), cA + kstep, voffA); PG8_STAGE(PG8_SB(1, 1), cB + hstep + kstep, voffB);
        PG8_WAIT_V(6); PG8_BAR;
    }
    for (;;) {
        const bool has_next = S.next(ui + 1, nxt);
        const char* nA = has_next ? (const char*)g.A + (size_t)nxt.pm * tstep : cA; const char* nB = has_next ? (const char*)g.Bt + (size_t)nxt.pn * tstep : cB;
        for (int t = 0; t < nt; t += 2) {
            if constexpr (Epi::HOOK) { if (t == Epi::H1 || t == Epi::H2) E.hook(acc, cur, t, wr, wc, fr, fq); }
            const bool last = (t == nt - 2);
            const char* a1 = cA + (size_t)(t + 1) * kstep;
            const char* a2 = last ? nA : cA + (size_t)(t + 2) * kstep; const char* b2 = last ? nB : cB + (size_t)(t + 2) * kstep;
            const char* a3 = a2 + kstep; const char* b3 = b2 + kstep;
            if (last && has_next) S.a_ready(nxt);
            if constexpr (SP2) {
            PG8_LDB(B0, 0, 0); PG8_LDB(B1, 0, 1); PG8_SCHED; PG8_LDA(At, 0, 0); PG8_STAGE(PG8_SA(1, 1), a1 + hstep, voffA);
            PG8_WAIT_V(8); PG8_WAIT_L(0); PG8_BAR; PG8_MMA(0, 0, At, B0); PG8_MMA(0, 1, At, B1); PG8_BAR; PG8_SCHED;
            PG8_LDA(At, 0, 1); PG8_STAGE(PG8_SB(0, 0), b2, voffB); PG8_STAGE(PG8_SB(0, 1), b2 + hstep, voffB); PG8_STAGE(PG8_SA(0, 0), a2, voffA);
            PG8_WAIT_V(8); PG8_WAIT_L(0); PG8_BAR; PG8_MMA(1, 0, At, B0); PG8_MMA(1, 1, At, B1); PG8_BAR; PG8_SCHED;
            PG8_LDB(B0, 1, 0); PG8_LDB(B1, 1, 1); PG8_SCHED; PG8_LDA(At, 1, 0); PG8_STAGE(PG8_SA(0, 1), a2 + hstep, voffA);
            PG8_WAIT_V(8); PG8_WAIT_L(0); PG8_BAR; PG8_MMA(0, 0, At, B0); PG8_MMA(0, 1, At, B1); PG8_BAR; PG8_SCHED;
            PG8_LDA(At, 1, 1); PG8_STAGE(PG8_SB(1, 0), b3, voffB); PG8_STAGE(PG8_SB(1, 1), b3 + hstep, voffB); PG8_STAGE(PG8_SA(1, 0), a3, voffA);
            PG8_WAIT_V(8); PG8_WAIT_L(0); PG8_BAR; PG8_MMA(1, 0, At, B0); PG8_MMA(1, 1, At, B1); PG8_BAR; PG8_SCHED;
            } else {
            PG8_LDB(B0, 0, 0); PG8_SCHED; PG8_LDA(At, 0, 0); PG8_STAGE(PG8_SA(1, 1), a1 + hstep, voffA);
            PG8_WAIT_L(8); PG8_BAR; PG8_WAIT_L(0); PG8_MMA(0, 0, At, B0); PG8_BAR; PG8_SCHED;
            PG8_LDB(B1, 0, 1); PG8_STAGE(PG8_SB(0, 0), b2, voffB);
            PG8_BAR; PG8_WAIT_L(0); PG8_MMA(0, 1, At, B1); PG8_BAR;
            PG8_LDA(At, 0, 1); PG8_STAGE(PG8_SA(0, 0), a2, voffA);
            PG8_BAR; PG8_WAIT_L(0); PG8_MMA(1, 0, At, B0); PG8_BAR; PG8_SCHED;
            PG8_STAGE(PG8_SB(0, 1), b2 + hstep, voffB);
            PG8_WAIT_V(6); PG8_BAR; PG8_MMA(1, 1, At, B1); PG8_BAR;
            PG8_LDB(B0, 1, 0); PG8_SCHED; PG8_LDA(At, 1, 0); PG8_STAGE(PG8_SA(0, 1), a2 + hstep, voffA);
            PG8_WAIT_L(8); PG8_BAR; PG8_WAIT_L(0); PG8_MMA(0, 0, At, B0); PG8_BAR; PG8_SCHED;
            PG8_LDB(B1, 1, 1); PG8_STAGE(PG8_SB(1, 0), b3, voffB);
            PG8_BAR; PG8_WAIT_L(0); PG8_MMA(0, 1, At, B1); PG8_BAR;
            PG8_LDA(At, 1, 1); PG8_STAGE(PG8_SA(1, 0), a3, voffA);
            PG8_BAR; PG8_WAIT_L(0); PG8_MMA(1, 0, At, B0); PG8_BAR; PG8_SCHED;
            PG8_STAGE(PG8_SB(1, 1), b3 + hstep, voffB);
            PG8_WAIT_V(6); PG8_BAR; PG8_MMA(1, 1, At, B1); PG8_BAR;
            }
        }
        if constexpr (ALIGN_EPI) { if (wr == 0) PG8_BAR; }
        if constexpr (!Epi::AFTER_DRAIN) { E(acc, cur, wr, wc, fr, fq); S.done(cur); }
        if (!has_next) break;
#pragma unroll
        for (int a = 0; a < 2; ++a)
#pragma unroll
            for (int b = 0; b < 2; ++b)
#pragma unroll
                for (int m = 0; m < 4; ++m)
#pragma unroll
                    for (int n = 0; n < 2; ++n) acc[a][b][m][n] = (f32x4){0.f, 0.f, 0.f, 0.f};
        cur = nxt; cA = nA; cB = nB; ++ui;
        if constexpr (ALIGN_EPI) { if (wr == 1) PG8_BAR; }
    }
    PG8_WAIT_V(0);
    if constexpr (!ALIGN_EPI) { if (wr == 0) PG8_BAR; }
    PG8_BAR;
    if constexpr (Epi::AFTER_DRAIN) { E.fused(acc, cur, wr, wc, fr, fq, lds, wid, lane); S.done(cur); }
#undef PG8_SA
#undef PG8_SB
#undef PG8_STAGE
#undef PG8_LDA
#undef PG8_LDB
#undef PG8_MMA
#undef PG8_WAIT_V
#undef PG8_WAIT_L
#undef PG8_BAR
#undef PG8_SCHED
}
}
#include <hip/hip_bf16.h>
#include <cmath>
namespace attn_body {
using bf16=__hip_bfloat16;
using bf16x8=__attribute__((ext_vector_type(8)))short;
using s16x4=__attribute__((ext_vector_type(4)))short;
using f32x16=__attribute__((ext_vector_type(16)))float;
using u32x4=__attribute__((ext_vector_type(4)))unsigned;
constexpr int BATCH=16,NHEAD=16,SEQ=2048,D=64,DM=NHEAD*D;
constexpr int NW=8,QBLK=32,QB=QBLK*NW,KVBLK=64,NQB=SEQ/QB;
constexpr int ATTN_PITCH=DM, ATTN_UNIT_ROWS=QB, OPITCH=2048;
__device__ __forceinline__ int crow(int r,int hi){return (r&3)+8*(r>>2)+4*hi;}
#define SBAR() __builtin_amdgcn_sched_barrier(0)
__device__ __forceinline__ void cmask(f32x16&p0,f32x16&p1,int jb,int qrel,int hi){
  const float NEG=-INFINITY; int kb=64*jb+4*hi;
  #pragma unroll
  for(int r=0;r<16;++r){int kv=kb+(r&3)+8*(r>>2); if(kv>qrel)p0[r]=NEG; if(kv+32>qrel)p1[r]=NEG;}
}

constexpr int NSLOT=3, SLOTB=8192;
constexpr int LDS_K=0, LDS_V=NSLOT*SLOTB, LDS_WS=2*NSLOT*SLOTB, LDS_OST=LDS_WS+NW*64*4, LDS_KB=LDS_OST+NW*4096, LDS_BYTES=LDS_KB+SEQ*4;
constexpr float C2=0.125f*1.4426950408889634f;
__device__ __forceinline__ void glds16(const void*gsrc,unsigned lds_dst){unsigned keep;
  asm volatile("s_mov_b32 %0, m0\n\ts_mov_b32 m0, %2\n\ts_nop 0\n\tglobal_load_lds_dwordx4 %1, off\n\ts_mov_b32 m0, %0":"=&s"(keep):"v"(gsrc),"s"(lds_dst):"memory");}
__device__ __forceinline__ float max3f(float a,float b,float c){float r;asm("v_max3_f32 %0, %1, %2, %3":"=v"(r):"v"(a),"v"(b),"v"(c));return r;}
__device__ __forceinline__ float max2f(float a,float b){float r;asm("v_max_f32_e32 %0, %1, %2":"=v"(r):"v"(a),"v"(b));return r;}
__device__ __forceinline__ float fadd_s(float a,float b){float r;asm("v_add_f32_e32 %0, %1, %2":"=v"(r):"v"(a),"v"(b));return r;}
__device__ __forceinline__ float fsub_s(float a,float b){float r;asm("v_sub_f32_e32 %0, %1, %2":"=v"(r):"v"(a),"v"(b));return r;}
typedef float f32x2_t __attribute__((ext_vector_type(2))); typedef __bf16 bf16x2_t __attribute__((ext_vector_type(2)));
__device__ __forceinline__ unsigned cvtpk_s(float lo,float hi){f32x2_t v={lo,hi};bf16x2_t b=__builtin_convertvector(v,bf16x2_t);return __builtin_bit_cast(unsigned,b);}
#define WAIT_BAR(N) asm volatile("s_waitcnt vmcnt(" #N ") lgkmcnt(0)\n\ts_barrier":::"memory")

__device__ __forceinline__ void qkt(f32x16&p0,f32x16&p1,const char*Kslot,const bf16x8*qr,int r32,int hi){
  const char*kb=Kslot+hi*1024+r32*16;
  #pragma unroll
  for(int d0=0;d0<4;++d0){
    const bf16x8 b0=*reinterpret_cast<const bf16x8*>(kb+d0*2048);
    const bf16x8 b1=*reinterpret_cast<const bf16x8*>(kb+d0*2048+512);
    {p0=__builtin_amdgcn_mfma_f32_32x32x16_bf16(b0,qr[d0],p0,0,0,0);p1=__builtin_amdgcn_mfma_f32_32x32x16_bf16(b1,qr[d0],p1,0,0,0);}}
}
typedef __attribute__((address_space(3))) const char* lds_cptr;
typedef short v4i16_t __attribute__((ext_vector_type(4)));
__device__ __forceinline__ void kload8(bf16x8*kf,lds_cptr kp){
  kf[0]=*(const __attribute__((address_space(3))) bf16x8*)(kp);      kf[1]=*(const __attribute__((address_space(3))) bf16x8*)(kp+512);
  kf[2]=*(const __attribute__((address_space(3))) bf16x8*)(kp+2048); kf[3]=*(const __attribute__((address_space(3))) bf16x8*)(kp+2560);
  kf[4]=*(const __attribute__((address_space(3))) bf16x8*)(kp+4096); kf[5]=*(const __attribute__((address_space(3))) bf16x8*)(kp+4608);
  kf[6]=*(const __attribute__((address_space(3))) bf16x8*)(kp+6144); kf[7]=*(const __attribute__((address_space(3))) bf16x8*)(kp+6656);
}
__device__ __forceinline__ void kload2(bf16x8*kf,lds_cptr kp,int j){ kf[2*j]=*(const __attribute__((address_space(3))) bf16x8*)(kp+j*2048); kf[2*j+1]=*(const __attribute__((address_space(3))) bf16x8*)(kp+j*2048+512); }
__device__ __forceinline__ s16x4 vtr(lds_cptr p){ return __builtin_bit_cast(s16x4,__builtin_amdgcn_ds_read_tr16_b64_v4i16((__attribute__((address_space(3))) v4i16_t*)p)); }
__device__ __forceinline__ float rowmax(const f32x16&p0,const f32x16&p1){
  float a=max3f(p0[0],p0[1],p1[0]),b=max3f(p0[2],p0[3],p1[1]);a=max3f(a,p1[2],p1[3]);
  #pragma unroll
  for(int r=4;r<16;r+=4){a=max3f(a,p0[r],p0[r+1]);b=max3f(b,p0[r+2],p0[r+3]);a=max3f(a,p1[r],p1[r+1]);b=max3f(b,p1[r+2],p1[r+3]);}
  const float m=max2f(a,b);
  auto rr=__builtin_amdgcn_permlane32_swap(__float_as_uint(m),__float_as_uint(m),false,false);
  return max2f(__uint_as_float(rr[0]),__uint_as_float(rr[1]));
}
__device__ __forceinline__ void pv(f32x16*o,int vb,bf16x8 pa0,bf16x8 pa1,bf16x8 pa2,bf16x8 pa3){
  #pragma unroll
  for(int d0=0;d0<2;++d0){s16x4 lo[4],hi[4];
    #pragma unroll
    for(int ks=0;ks<4;++ks){
      asm volatile("ds_read_b64_tr_b16 %0,%1 offset:%c2":"=&v"(lo[ks]):"v"(vb),"i"(d0*4096+ks*1024):"memory");
      asm volatile("ds_read_b64_tr_b16 %0,%1 offset:%c2":"=&v"(hi[ks]):"v"(vb),"i"(d0*4096+ks*1024+512):"memory");}
    asm volatile("s_waitcnt lgkmcnt(0)":::"memory");SBAR();
    #define PK(k) (bf16x8){lo[k][0],lo[k][1],lo[k][2],lo[k][3],hi[k][0],hi[k][1],hi[k][2],hi[k][3]}
    o[d0]=__builtin_amdgcn_mfma_f32_32x32x16_bf16(pa0,PK(0),o[d0],0,0,0);
    o[d0]=__builtin_amdgcn_mfma_f32_32x32x16_bf16(pa1,PK(1),o[d0],0,0,0);
    o[d0]=__builtin_amdgcn_mfma_f32_32x32x16_bf16(pa2,PK(2),o[d0],0,0,0);
    o[d0]=__builtin_amdgcn_mfma_f32_32x32x16_bf16(pa3,PK(3),o[d0],0,0,0);
    #undef PK
  }
}

#ifndef ATTN_STORE16
#define ATTN_STORE16(p,v) (*(u32x4*)(p)=(v))
#endif
template<int THRL> __device__ __forceinline__ void attn_unit(int b,int h,int qb,const bf16*Q,const bf16*__restrict__ K,const bf16*__restrict__ V,bf16*O,const float*__restrict__ CL,char*shm,bool pre,bool nxt){
  const int tid=threadIdx.x,lane=tid&63,r32=lane&31,hi=lane>>5; const int wid=__builtin_amdgcn_readfirstlane(tid>>6);
  const long rowbase=(long)b*SEQ; const int q0=qb*QB;
  const bf16*Qw=Q+(rowbase+q0+wid*QBLK)*DM+h*D;
  const bf16*Kh=K+rowbase*DM+h*D,*Vh=V+rowbase*DM+h*D;
  const unsigned lds0=(unsigned)(uintptr_t)shm;
  float*wsf=(float*)(shm+LDS_WS)+wid*64;
  typedef __attribute__((address_space(3))) float lds_f32; typedef float f32x4_t __attribute__((ext_vector_type(4)));
  lds_f32*kbl3=(lds_f32*)((__attribute__((address_space(3))) char*)shm+LDS_KB);
  const float clq=-kbl3[qb*QB+wid*QBLK+(lane&31)];
  const bf16*ksrc=Kh+(long)lane*DM+wid*8;
  const bf16*vsrc=Vh+(long)(16*(wid&3)+(lane>>2))*DM+(wid>>2)*32+(lane&3)*8;
  const unsigned kdst=lds0+LDS_K+wid*1024, vdst=lds0+LDS_V+wid*1024;
  #define DMA_K(t,slot) glds16(ksrc+(long)(t)*KVBLK*DM,(unsigned)__builtin_amdgcn_readfirstlane(kdst+(slot)))
  #define DMA_V(t,slot) glds16(vsrc+(long)(t)*KVBLK*DM,(unsigned)__builtin_amdgcn_readfirstlane(vdst+(slot)))
  const int vb0=(int)(lds0+LDS_V)+((lane>>4)&1)*32+(lane&3)*8+(4*hi+((lane&15)>>2))*64;
  const char*Kbase=shm+LDS_K; bf16x8 kf[8];
  const lds_cptr shm3=(lds_cptr)shm; const lds_cptr kp0=shm3+LDS_K+hi*1024+r32*16; const lds_cptr vp0=shm3+LDS_V+((lane>>4)&1)*32+(lane&3)*8+(4*hi+((lane&15)>>2))*64;
  const int NT=(q0+QB)/KVBLK;
  if(!pre){DMA_K(0,0);DMA_V(0,0);DMA_K(1,SLOTB);}
  bf16x8 qr[4];
  #pragma unroll
  for(int d0=0;d0<4;++d0)qr[d0]=*reinterpret_cast<const bf16x8*>(&Qw[(long)r32*DM+d0*16+hi*8]);
  float mhat=-clq,l_reg=0.f;f32x16 o[2];o[0]=f32x16{};o[1]=f32x16{};
  #define KINIT(X0,X1,t) do{ const __attribute__((address_space(3))) f32x4_t* kb_=(const __attribute__((address_space(3))) f32x4_t*)(kbl3+(t)*KVBLK+4*hi); \
    _Pragma("unroll") for(int g_=0;g_<4;++g_){ const f32x4_t ka_=kb_[2*g_], kc_=kb_[2*g_+8]; \
      X0[4*g_]=ka_[0]-mhat;X0[4*g_+1]=ka_[1]-mhat;X0[4*g_+2]=ka_[2]-mhat;X0[4*g_+3]=ka_[3]-mhat; X1[4*g_]=kc_[0]-mhat;X1[4*g_+1]=kc_[1]-mhat;X1[4*g_+2]=kc_[2]-mhat;X1[4*g_+3]=kc_[3]-mhat; } }while(0)
  #define KLOAD(X0,X1,t) do{ const __attribute__((address_space(3))) f32x4_t* kb_=(const __attribute__((address_space(3))) f32x4_t*)(kbl3+(t)*KVBLK+4*hi); \
    _Pragma("unroll") for(int g_=0;g_<4;++g_){ const f32x4_t ka_=kb_[2*g_], kc_=kb_[2*g_+8]; \
      X0[4*g_]=ka_[0];X0[4*g_+1]=ka_[1];X0[4*g_+2]=ka_[2];X0[4*g_+3]=ka_[3]; X1[4*g_]=kc_[0];X1[4*g_+1]=kc_[1];X1[4*g_+2]=kc_[2];X1[4*g_+3]=kc_[3]; } }while(0)
  #define KSUB(X0,X1) do{ _Pragma("unroll") for(int r_=0;r_<16;++r_){ X0[r_]-=mhat; X1[r_]-=mhat; } }while(0)
  const int qrel=wid*QBLK+r32;
  #define CMASK(P0,P1,t) do{int jb_=(t)-(NT-4); if(jb_>=0)cmask(P0,P1,jb_,qrel,hi);}while(0)
  bool resc=false;
  #define START(P0,P1) do{ const float rm=rowmax(P0,P1); resc=false; \
    { const float dl=rm; mhat=fadd_s(mhat,dl); \
      _Pragma("unroll") for(int r=0;r<16;++r){P0[r]=fsub_s(P0[r],dl);P1[r]=fsub_s(P1[r],dl);} \
      } \
    _Pragma("unroll") for(int r=0;r<16;++r)P0[r]=__builtin_amdgcn_exp2f(P0[r]); }while(0)
  #define RESC() do{ if(resc){ asm volatile("s_waitcnt lgkmcnt(0)":::"memory"); \
      _Pragma("unroll") for(int d_=0;d_<2;++d_) _Pragma("unroll") for(int r=0;r<16;++r)o[d_][r]*=wsf[crow(r,hi)]; } }while(0)
  f32x16 pA0,pA1,pB0,pB1;
  int sl_prev=0,sl_cur=0,sl_next=SLOTB;
  #define ROT() do{sl_prev=sl_cur;sl_cur=sl_next;sl_next=(sl_next==(NSLOT-1)*SLOTB)?0:sl_next+SLOTB;}while(0)
  if(!pre){DMA_K(2,2*SLOTB);}
  WAIT_BAR(3);
  KINIT(pA0,pA1,0);qkt(pA0,pA1,Kbase,qr,r32,hi);asm volatile("s_nop 15\n\ts_nop 7":"+v"(pA0),"+v"(pA1));CMASK(pA0,pA1,0);
  START(pA0,pA1);
  _Pragma("unroll") for(int r=0;r<16;++r)pA1[r]=__builtin_amdgcn_exp2f(pA1[r]);
  KINIT(pB0,pB1,1);
  WAIT_BAR(0);
  DMA_K(3,0);DMA_V(1,SLOTB);
  ROT();
  kload8(kf,kp0+sl_cur);
  WAIT_BAR(2);
  s16x4 vlo[8],vhi[8]; u32x4 pw0,pw1,pw2,pw3;
  #define PKW(P,B) cvtpk_s(P[B],P[B+1])
  #define PAF(k) __builtin_bit_cast(bf16x8,pw##k)
  #define VFR(i) (bf16x8){vlo[i][0],vlo[i][1],vlo[i][2],vlo[i][3],vhi[i][0],vhi[i][1],vhi[i][2],vhi[i][3]}
  #define PIN(x) asm volatile("":"+v"(x))
  #define MX3(a,b,c) __builtin_fmaxf(__builtin_fmaxf((a),(b)),(c))
  #define GAPA(MF,A0,A1,A2,A3,W0,W1,PW) do{ MF; sacc+=A0; sacc+=A1; sacc+=A2; sacc+=A3; PIN(sacc); W0; W1; PIN(PW); SBAR(); }while(0)
  #define EX(v) __builtin_amdgcn_exp2f(v)
  #define GAPB(MF,X,B) do{ MF; X[B]=EX(X[B]); X[B+1]=EX(X[B+1]); X[B+2]=EX(X[B+2]); X[B+3]=EX(X[B+3]); PIN(X); SBAR(); }while(0)
  #define VRD(i) do{ vlo[i]=vtr(vp_+(((i)>>2)*4096+((i)&3)*1024)); vhi[i]=vtr(vp_+(((i)>>2)*4096+((i)&3)*1024+512)); }while(0)
  #define KRD(G,j) do{ if(G){ kload2(kf,kp0+sl_next,j); SBAR(); } }while(0)
  #define STEP(C0,C1,P0,P1,t,GK,GV,GL) do{ SBAR(); \
    const lds_cptr vp_=vp0+sl_prev; \
    VRD(0); SBAR(); float sacc=(P0[0]+P0[1]); \
    GAPA(C0=__builtin_amdgcn_mfma_f32_32x32x16_bf16(kf[0],qr[0],C0,0,0,0), P0[2],P0[3],P0[4],P0[5],     pw0[0]=PKW(P0,0), pw0[1]=PKW(P0,2), pw0); \
    VRD(4); SBAR(); GAPA(C1=__builtin_amdgcn_mfma_f32_32x32x16_bf16(kf[1],qr[0],C1,0,0,0), P0[6],P0[7],P0[8],P0[9],     pw0[2]=PKW(P0,4), pw0[3]=PKW(P0,6), pw0); \
    VRD(1); SBAR(); GAPA(C0=__builtin_amdgcn_mfma_f32_32x32x16_bf16(kf[2],qr[1],C0,0,0,0),   P0[10],P0[11],P0[12],P0[13], pw1[0]=PKW(P0,8), pw1[1]=PKW(P0,10), pw1); \
    VRD(5); SBAR(); GAPA(C1=__builtin_amdgcn_mfma_f32_32x32x16_bf16(kf[3],qr[1],C1,0,0,0),   P0[14],P0[15],P1[0],P1[1],   pw1[2]=PKW(P0,12),pw1[3]=PKW(P0,14), pw1); \
    VRD(2); SBAR(); GAPA(C0=__builtin_amdgcn_mfma_f32_32x32x16_bf16(kf[4],qr[2],C0,0,0,0),   P1[2],P1[3],P1[4],P1[5],     pw2[0]=PKW(P1,0), pw2[1]=PKW(P1,2), pw2); \
    VRD(6); SBAR(); GAPA(C1=__builtin_amdgcn_mfma_f32_32x32x16_bf16(kf[5],qr[2],C1,0,0,0),   P1[6],P1[7],P1[8],P1[9],     pw2[2]=PKW(P1,4), pw2[3]=PKW(P1,6), pw2); \
    VRD(3); SBAR(); GAPA(C0=__builtin_amdgcn_mfma_f32_32x32x16_bf16(kf[6],qr[3],C0,0,0,0),   P1[10],P1[11],P1[12],P1[13], pw3[0]=PKW(P1,8), pw3[1]=PKW(P1,10), pw3); \
    VRD(7); SBAR(); GAPA(C1=__builtin_amdgcn_mfma_f32_32x32x16_bf16(kf[7],qr[3],C1,0,0,0),   P1[14],P1[15],0.f,0.f,       pw3[2]=PKW(P1,12),pw3[3]=PKW(P1,14), pw3); \
    l_reg+=sacc; \
    if(GK){DMA_K((t)+3,sl_cur);} if(GV){DMA_V((t)+1,sl_next);} \
    CMASK(C0,C1,t); \
    { float a=MX3(C0[0],C0[1],C1[0]),b=MX3(C0[2],C0[3],C1[1]); a=MX3(a,C1[2],C1[3]); \
      _Pragma("unroll") for(int r=4;r<16;r+=4){a=MX3(a,C0[r],C0[r+1]);b=MX3(b,C0[r+2],C0[r+3]);a=MX3(a,C1[r],C1[r+1]);b=MX3(b,C1[r+2],C1[r+3]);} \
      float rm=__builtin_fmaxf(a,b); { auto rr=__builtin_amdgcn_permlane32_swap(__float_as_uint(rm),__float_as_uint(rm),false,false); rm=__builtin_fmaxf(__uint_as_float(rr[0]),__uint_as_float(rr[1])); } \
      resc=false; \
      if(__builtin_expect(__any(rm>(float)THRL),0)){ const float dl=__builtin_fmaxf(rm,0.f); mhat+=dl; \
        _Pragma("unroll") for(int r=0;r<16;++r){C0[r]-=dl;C1[r]-=dl;} \
        const float f=__builtin_amdgcn_exp2f(-dl); l_reg*=f; if(hi==0)wsf[r32]=f; resc=true; } } \
    SBAR(); \
    if(GV){ KLOAD(P0,P1,(t)+1); } SBAR(); \
    GAPB(o[0]=__builtin_amdgcn_mfma_f32_32x32x16_bf16(PAF(0),VFR(0),o[0],0,0,0), C0,0); \
    GAPB(o[1]=__builtin_amdgcn_mfma_f32_32x32x16_bf16(PAF(0),VFR(4),o[1],0,0,0), C0,4); \
    KRD(GL,0); GAPB(o[0]=__builtin_amdgcn_mfma_f32_32x32x16_bf16(PAF(1),VFR(1),o[0],0,0,0), C0,8); \
    KRD(GL,1); GAPB(o[1]=__builtin_amdgcn_mfma_f32_32x32x16_bf16(PAF(1),VFR(5),o[1],0,0,0), C0,12); \
    KRD(GL,2); GAPB(o[0]=__builtin_amdgcn_mfma_f32_32x32x16_bf16(PAF(2),VFR(2),o[0],0,0,0), C1,0); \
    KRD(GL,3); GAPB(o[1]=__builtin_amdgcn_mfma_f32_32x32x16_bf16(PAF(2),VFR(6),o[1],0,0,0), C1,4); \
    GAPB(o[0]=__builtin_amdgcn_mfma_f32_32x32x16_bf16(PAF(3),VFR(3),o[0],0,0,0), C1,8); \
    GAPB(o[1]=__builtin_amdgcn_mfma_f32_32x32x16_bf16(PAF(3),VFR(7),o[1],0,0,0), C1,12); \
    if(GV){ KSUB(P0,P1); } \
    }while(0)
  int t=1;
  #undef CMASK
  #define CMASK(P0,P1,t) do{}while(0)
  for(;t+5<NT;t+=2){
    STEP(pB0,pB1,pA0,pA1,t,true,true,true);     WAIT_BAR(2); RESC(); ROT();
    STEP(pA0,pA1,pB0,pB1,t+1,true,true,true);   WAIT_BAR(2); RESC(); ROT();
  }
  #undef CMASK
  #define CMASK(P0,P1,t) do{int jb_=(t)-(NT-4); if(jb_>=0)cmask(P0,P1,jb_,qrel,hi);}while(0)
  #define ENDW(tt) do{ if((tt)+3<NT){WAIT_BAR(2);} else if((tt)+2<NT){WAIT_BAR(1);} else {WAIT_BAR(0);} }while(0)
  for(;t+1<NT;t+=2){
    STEP(pB0,pB1,pA0,pA1,t,(t+3<NT),(t+1<NT),(t+1<NT));       ENDW(t);   RESC(); ROT();
    STEP(pA0,pA1,pB0,pB1,t+1,(t+4<NT),(t+2<NT),(t+2<NT));     ENDW(t+1); RESC(); ROT();
  }
  STEP(pB0,pB1,pA0,pA1,NT-1,false,false,false); RESC();
  { float sacc=pB0[0]+pB0[1]; _Pragma("unroll") for(int r=2;r<16;++r)sacc+=pB0[r]; _Pragma("unroll") for(int r=0;r<16;++r)sacc+=pB1[r]; l_reg+=sacc;
    pw0=(u32x4){PKW(pB0,0),PKW(pB0,2),PKW(pB0,4),PKW(pB0,6)};pw1=(u32x4){PKW(pB0,8),PKW(pB0,10),PKW(pB0,12),PKW(pB0,14)};pw2=(u32x4){PKW(pB1,0),PKW(pB1,2),PKW(pB1,4),PKW(pB1,6)};pw3=(u32x4){PKW(pB1,8),PKW(pB1,10),PKW(pB1,12),PKW(pB1,14)};
    SBAR(); pv(o,vb0+sl_cur,PAF(0),PAF(1),PAF(2),PAF(3)); }
  if(nxt){ asm volatile("s_waitcnt lgkmcnt(0)\n\ts_barrier":::"memory"); DMA_K(0,0);DMA_V(0,0);DMA_K(1,SLOTB);DMA_K(2,2*SLOTB); }
  #undef PKW
  #undef PAF
  #undef VFR
  #undef PIN
  #undef MX3
  #undef GAPA
  #undef GAPB
  #undef EX
  #undef VRD
  #undef KRD
  #undef STEP
  #undef ENDW
  {auto rr=__builtin_amdgcn_permlane32_swap(__float_as_uint(l_reg),__float_as_uint(l_reg),false,false);l_reg=__uint_as_float(rr[0])+__uint_as_float(rr[1]);}
  if(hi==0)wsf[32+r32]=l_reg;asm volatile("s_waitcnt lgkmcnt(0)":::"memory");
  float rli[16];
  #pragma unroll
  for(int r=0;r<16;++r)rli[r]=__builtin_amdgcn_rcpf(wsf[32+crow(r,hi)]);
  bf16*Ow=O+(rowbase+q0+wid*QBLK)*OPITCH+h*D;
  { bf16*stg=(bf16*)(shm+LDS_OST)+wid*2048;
    #pragma unroll
    for(int r=0;r<16;++r){const int orow=crow(r,hi);
      #pragma unroll
      for(int d0=0;d0<2;++d0)stg[orow*64+d0*32+r32]=__float2bfloat16(o[d0][r]*rli[r]);}
    asm volatile("s_waitcnt lgkmcnt(0)":::"memory");
    #pragma unroll
    for(int i=0;i<4;++i){const int row=i*8+(lane>>3),ch=lane&7; const u32x4 v=*(const u32x4*)(stg+row*64+ch*8); ATTN_STORE16(Ow+(long)row*OPITCH+ch*8,v);} }
  asm volatile("s_waitcnt lgkmcnt(0)\n\ts_barrier":::"memory");
  #undef KINIT
  #undef KLOAD
  #undef KSUB
  #undef DMA_K
  #undef DMA_V
  #undef CMASK
  #undef START
  #undef RESC
  #undef ROT
}
constexpr int ATTN_LDS_BYTES=LDS_BYTES;
struct AttnTensors { const bf16* Q; const bf16* K; const bf16* V; bf16* O; const float* CL; };
struct AttnUnit { int bh; int qb; };
struct StaticOrder {
  int vcu, G;
  __device__ __forceinline__ explicit StaticOrder(int grid,int v):vcu(v),G(grid){}
  __device__ __forceinline__ bool next(int i,AttnUnit&u)const{ const int bh=vcu+(i/NQB)*G; if(bh>=BATCH*NHEAD)return false; u.bh=bh; u.qb=NQB-1-(i%NQB); return true; }
  __device__ __forceinline__ void a_ready(const AttnUnit&)const{}
  __device__ __forceinline__ void done(const AttnUnit&)const{}
};
__device__ __forceinline__ void build_bias(int b,int h,const float*__restrict__ LOGF,char*shm){
  typedef __attribute__((address_space(3))) float lds_f32; typedef float f32x4_t __attribute__((ext_vector_type(4)));
  const int tid=threadIdx.x,lane=tid&63; const int wid=__builtin_amdgcn_readfirstlane(tid>>6);
  lds_f32*kbl3=(lds_f32*)((__attribute__((address_space(3))) char*)shm+LDS_KB); lds_f32*wtot=(lds_f32*)((__attribute__((address_space(3))) char*)shm+LDS_WS);
  const float*src=LOGF+((long)b*SEQ+4*tid)*NHEAD+h;
  float a0=src[0],a1=src[NHEAD],a2=src[2*NHEAD],a3=src[3*NHEAD]; a1+=a0;a2+=a1;a3+=a2;
  float inc=a3;
  #pragma unroll
  for(int o=1;o<64;o<<=1){ const float t=__shfl_up(inc,o); if(lane>=o)inc+=t; }
  if(lane==63)wtot[wid]=inc;
  asm volatile("s_waitcnt lgkmcnt(0)\n\ts_barrier":::"memory");
  float base=0.f;
  #pragma unroll
  for(int w=0;w<NW;++w){ const float t=wtot[w]; if(w<wid)base+=t; }
  const float ex=base+inc-a3; const float c=-1.4426950408889634f;
  *(__attribute__((address_space(3))) f32x4_t*)(kbl3+4*tid)=(f32x4_t){(ex+a0)*c,(ex+a1)*c,(ex+a2)*c,(ex+a3)*c};
  asm volatile("s_waitcnt lgkmcnt(0)\n\ts_barrier":::"memory");
}
template<class Sched,int THRL=8> __device__ __forceinline__ void attn_phase(char*lds,const AttnTensors&T,const Sched&S){
  AttnUnit u,un; int cur_bh=-1; bool have=S.next(0,u);
  for(int i=0;have;++i){ const bool fresh=(u.bh!=cur_bh); if(fresh){ build_bias(u.bh/NHEAD,u.bh%NHEAD,T.CL,lds); cur_bh=u.bh; }
    const bool hn=S.next(i+1,un); const bool nxt=hn&&(un.bh==u.bh);
    S.a_ready(u); attn_unit<THRL>(u.bh/NHEAD,u.bh%NHEAD,u.qb,T.Q,T.K,T.V,T.O,T.CL,lds,!fresh,nxt); S.done(u);
    u=un; have=hn; }
}
#undef SBAR
#undef WAIT_BAR
}
namespace memattn {
using attn_body::bf16x8; using attn_body::f32x16; using attn_body::s16x4; using attn_body::u32x4;
#define MLAS __attribute__((address_space(3)))
constexpr int KSTR = 272, VSTR = 520, K_OFF = 0, V_OFF = 256 * KSTR, WSF_OFF = V_OFF + 128 * VSTR, MEM_LDS_BYTES = WSF_OFF + 8 * 256;
__device__ __forceinline__ void stage_kv(int b, int hm, const unsigned short* KM, const unsigned short* VT, const float* kgain, MLAS unsigned char* L) {
    int tid = threadIdx.x; asm volatile("" : "+v"(tid));
    { const int c = tid & 15, r0 = tid >> 4;
      const unsigned short* src = KM + ((long)b * 256 + r0) * 512 + hm * 128 + c * 8;
      float g[8];
#pragma unroll
      for (int j = 0; j < 8; ++j) g[j] = kgain[c * 8 + j];
      u32x4 vv[8];
#pragma unroll
      for (int p = 0; p < 8; ++p) vv[p] = *reinterpret_cast<const u32x4*>(src + (long)p * 32 * 512);
#pragma unroll
      for (int p = 0; p < 8; ++p) { const u32x4 v = vv[p];
          float f[8] = {__uint_as_float(v.x << 16), __uint_as_float(v.x & 0xffff0000u), __uint_as_float(v.y << 16), __uint_as_float(v.y & 0xffff0000u), __uint_as_float(v.z << 16), __uint_as_float(v.z & 0xffff0000u), __uint_as_float(v.w << 16), __uint_as_float(v.w & 0xffff0000u)};
          float ss = 0.f;
#pragma unroll
          for (int j = 0; j < 8; ++j) ss += f[j] * f[j];
          ss += __shfl_xor(ss, 1); ss += __shfl_xor(ss, 2); ss += __shfl_xor(ss, 4); ss += __shfl_xor(ss, 8);
          const float r = 1.0f / sqrtf(ss * (1.0f / 128.0f) + 1e-6f);
          u32x4 o; o.x = attn_body::cvtpk_s(f[0] * r * g[0], f[1] * r * g[1]); o.y = attn_body::cvtpk_s(f[2] * r * g[2], f[3] * r * g[3]); o.z = attn_body::cvtpk_s(f[4] * r * g[4], f[5] * r * g[5]); o.w = attn_body::cvtpk_s(f[6] * r * g[6], f[7] * r * g[7]);
          *(MLAS u32x4*)(L + K_OFF + (p * 32 + r0) * KSTR + c * 16) = o; } }
    { const int c = tid & 31, r0 = tid >> 5;
      typedef unsigned u32x2_t __attribute__((ext_vector_type(2)));
      const unsigned short* src = VT + ((long)hm * 128 + r0) * 4096 + b * 256 + c * 8;
#pragma unroll
      for (int p = 0; p < 8; ++p) { const u32x4 v = *reinterpret_cast<const u32x4*>(src + (long)p * 16 * 4096); MLAS unsigned char* d = L + V_OFF + (p * 16 + r0) * VSTR + c * 16;
          *(MLAS u32x2_t*)d = (u32x2_t){v.x, v.y}; *(MLAS u32x2_t*)(d + 8) = (u32x2_t){v.z, v.w}; } }
}
__device__ __forceinline__ void unit(int b, int hm, int qb, const unsigned short* QM, unsigned short* OM, MLAS unsigned char* L) {
    int tid = threadIdx.x; asm volatile("" : "+v"(tid)); const int lane = tid & 63, r32 = lane & 31, hi = lane >> 5; const int wid = __builtin_amdgcn_readfirstlane(tid >> 6);
    MLAS float* wsf = (MLAS float*)(L + WSF_OFF + wid * 256);
    const long row0 = (long)b * 2048 + qb * 256 + wid * 32;
    const unsigned short* Qw = QM + (row0 + r32) * 512 + hm * 128 + hi * 8;
    bf16x8 qr[8];
#pragma unroll
    for (int d0 = 0; d0 < 8; ++d0) qr[d0] = *reinterpret_cast<const bf16x8*>(Qw + d0 * 16);
    const MLAS unsigned char* Kb = L + K_OFF + r32 * KSTR + hi * 16;
    f32x16 s[8];
#pragma unroll
    for (int kb = 0; kb < 8; ++kb) { f32x16 a = f32x16{};
#pragma unroll
        for (int d0 = 0; d0 < 8; ++d0) { const bf16x8 kf = *(const MLAS bf16x8*)(Kb + kb * 32 * KSTR + d0 * 32); a = __builtin_amdgcn_mfma_f32_32x32x16_bf16(kf, qr[d0], a, 0, 0, 0); }
        s[kb] = a; }
    float mx = s[0][0];
#pragma unroll
    for (int kb = 0; kb < 8; ++kb)
#pragma unroll
        for (int r = 0; r < 16; ++r) mx = fmaxf(mx, s[kb][r]);
    mx = fmaxf(mx, __shfl_xor(mx, 32));
    float l = 0.f;
#pragma unroll
    for (int kb = 0; kb < 8; ++kb)
#pragma unroll
        for (int r = 0; r < 16; ++r) { const float e = __builtin_amdgcn_exp2f(s[kb][r] - mx); s[kb][r] = e; l += e; }
    l += __shfl_xor(l, 32);
    if (hi == 0) wsf[r32] = l;
    const MLAS unsigned char* Vb = L + V_OFF + r32 * VSTR + hi * 8;
    f32x16 o[4]; o[0] = f32x16{}; o[1] = f32x16{}; o[2] = f32x16{}; o[3] = f32x16{};
#pragma unroll
    for (int ks = 0; ks < 16; ++ks) { const int kb = ks >> 1, h8 = (ks & 1) * 8;
        u32x4 pw; pw.x = attn_body::cvtpk_s(s[kb][h8 + 0], s[kb][h8 + 1]); pw.y = attn_body::cvtpk_s(s[kb][h8 + 2], s[kb][h8 + 3]); pw.z = attn_body::cvtpk_s(s[kb][h8 + 4], s[kb][h8 + 5]); pw.w = attn_body::cvtpk_s(s[kb][h8 + 6], s[kb][h8 + 7]);
        const bf16x8 pa = __builtin_bit_cast(bf16x8, pw);
#pragma unroll
        for (int db = 0; db < 4; ++db) { const MLAS unsigned char* vp = Vb + db * 32 * VSTR + ks * 32;
            const s16x4 lo = *(const MLAS s16x4*)vp, h4 = *(const MLAS s16x4*)(vp + 16);
            const bf16x8 vf = (bf16x8){lo[0], lo[1], lo[2], lo[3], h4[0], h4[1], h4[2], h4[3]};
            o[db] = __builtin_amdgcn_mfma_f32_32x32x16_bf16(pa, vf, o[db], 0, 0, 0); } }
    asm volatile("s_waitcnt lgkmcnt(0)" ::: "memory");
    unsigned short* Ow = OM + row0 * 2048 + hm * 128 + r32;
#pragma unroll
    for (int r = 0; r < 16; ++r) { const int q = attn_body::crow(r, hi); const float rl = __builtin_amdgcn_rcpf(wsf[q]);
#pragma unroll
        for (int db = 0; db < 4; ++db) { const unsigned w = attn_body::cvtpk_s(o[db][r] * rl, 0.f); Ow[(long)q * 2048 + db * 32] = (unsigned short)(w & 0xffffu); } }
    asm volatile("s_waitcnt lgkmcnt(0)" ::: "memory");
}
#undef MLAS
}

constexpr int NWAVES = 8;
#ifndef MK_N_LAUNCHES
#define MK_N_LAUNCHES 1
#endif
constexpr int NPH = 12;
#ifndef PROBE_DOUBLE_MASK
#define PROBE_DOUBLE_MASK 0
#endif
constexpr int B_ = 16, S_ = 2048, DM_ = 2048, M_ = B_ * S_, FF_ = 5632, MEML = 256, MM_ = B_ * MEML;
constexpr int NWIN = 10496, NWIN_SRC = 10256;
constexpr float EPS_ = 1e-6f, LOG2E = 1.4426950408889634f;
constexpr size_t MiB = 1u << 20;
constexpr size_t WS_GU = 1 * MiB, WS_DN = 45 * MiB, WS_WIN = 67 * MiB, WS_WMKV = 108 * MiB, WS_WCAT = 112 * MiB, WS_WO = 120 * MiB;
constexpr size_t WS_H = 128 * MiB;
constexpr size_t WS_MEMN = 256 * MiB, WS_KM = 272 * MiB, WS_VT = 276 * MiB, WS_LOGF = 280 * MiB, WS_CL = 282 * MiB;
constexpr size_t WS_BIG = 284 * MiB;
constexpr size_t WS_UP = WS_BIG, WS_PD = WS_BIG + 32 * MiB, WS_QF = WS_BIG + 64 * MiB, WS_KF = WS_BIG + 128 * MiB, WS_VF = WS_BIG + 192 * MiB, WS_QM = WS_BIG + 256 * MiB, WS_GATE = WS_BIG + 288 * MiB;
constexpr size_t WS_END = WS_GATE + 384 * MiB;
constexpr size_t WS_BAR = 512 * 1024, WS_BAR_BYTES = 16384;
constexpr size_t WS_SSQ1 = 0, WS_SSQ2 = 256 * 1024;
constexpr size_t WS_H3 = WS_BIG + 352 * MiB;
static_assert(WS_BIG + (size_t)M_ * FF_ * 2 <= WS_END && WS_WO + 8 * MiB <= WS_H && WS_WIN + (size_t)NWIN * DM_ * 2 <= WS_WMKV, "d_ws map");
constexpr int RING_BYTES = 131072, LDS_BYTES = 147456;
static_assert(attn_body::ATTN_LDS_BYTES <= RING_BYTES && memattn::MEM_LDS_BYTES <= LDS_BYTES, "attention scratch fits");

#define GAS __attribute__((address_space(1)))
#define LAS __attribute__((address_space(3)))
typedef unsigned short bf16;
typedef unsigned v4u __attribute__((ext_vector_type(4)));
typedef unsigned v2u __attribute__((ext_vector_type(2)));
typedef float f32x4 __attribute__((ext_vector_type(4)));
#define LDS_WAIT() asm volatile("s_waitcnt lgkmcnt(0)" ::: "memory")
__device__ __forceinline__ unsigned f2bf(float f) { unsigned u = __builtin_bit_cast(unsigned, f); return (u + 0x7fffu + ((u >> 16) & 1u)) >> 16; }
__device__ __forceinline__ unsigned pk2(float lo, float hi) { return f2bf(lo) | (f2bf(hi) << 16); }
__device__ __forceinline__ float wave_sum(float v) {
#pragma unroll
    for (int o = 1; o < 64; o <<= 1) v += __shfl_xor(v, o);
    return v;
}
__device__ __forceinline__ int dmap(int map, int n) {
    if (map == 1) { const int up = n >= FF_ ? 1 : 0; const int c = up ? n - FF_ : n; return (c >> 7) * 256 + up * 128 + (c & 127); }
    if (map == 2) { return n < 3584 ? n : (n < 3600 ? 10240 + (n - 3584) : n - 16); }
    return n;
}
__device__ __forceinline__ float colscale(int map, int n) {
    if (map == 1) return n < FF_ ? LOG2E : (1.0f / LOG2E);
    if (map == 2) return n >= 4112 ? LOG2E : 1.0f;
    return 1.0f;
}
constexpr int TSCR = 64 * 65 * 4;
__device__ __forceinline__ void transpose_item(const float* W, int K, int N, bf16* WT, int map, LAS float* scr, int item, int lane, int ldk = 0, int koff = 0, const float* kgain = nullptr) {
    if (ldk == 0) ldk = K;
    const int nblk = (N + 63) / 64, kb = item / nblk, nb = item % nblk, k0 = 64 * kb, n0 = 64 * nb;
    const int kq = lane >> 4, c = lane & 15, nc = n0 + 4 * c; const bool okc = nc < N;
    f32x4 v[16];
    const float* src = W + (size_t)(k0 + kq) * N + nc;
#pragma unroll
    for (int i = 0; i < 16; ++i) v[i] = okc ? *(const f32x4*)(src + (size_t)(4 * i) * N) : (f32x4){0.f, 0.f, 0.f, 0.f};
#pragma unroll
    for (int i = 0; i < 16; ++i) { LAS float* d = scr + (4 * i + kq) * 65 + 4 * c; const float kg = kgain ? kgain[k0 + 4 * i + kq] : 1.0f;
        d[0] = v[i].x * kg; d[1] = v[i].y * kg; d[2] = v[i].z * kg; d[3] = v[i].w * kg; }
    LDS_WAIT(); asm volatile("" ::: "memory");
    const int cc = lane & 7, nn = lane >> 3;
#pragma unroll
    for (int j = 0; j < 8; ++j) { const int n = nn + 8 * j; const LAS float* s = scr + (8 * cc) * 65 + n; const float cs = colscale(map, n0 + n);
        v4u o; o.x = pk2(s[0 * 65] * cs, s[1 * 65] * cs); o.y = pk2(s[2 * 65] * cs, s[3 * 65] * cs); o.z = pk2(s[4 * 65] * cs, s[5 * 65] * cs); o.w = pk2(s[6 * 65] * cs, s[7 * 65] * cs);
        if (n0 + n < N) *(v4u*)(WT + (size_t)dmap(map, n0 + n) * ldk + koff + k0 + 8 * cc) = o; }
    LDS_WAIT(); asm volatile("" ::: "memory");
}
__device__ __forceinline__ int transpose_items(int K, int N) { return (K / 64) * ((N + 63) / 64); }
__device__ __forceinline__ void norm_row(const float* xrow, const float* gain, bf16* orow, int lane) {
    const f32x4* xr = (const f32x4*)xrow + lane; const f32x4* gr = (const f32x4*)gain + lane;
    f32x4 v[8]; float s = 0.f;
#pragma unroll
    for (int j = 0; j < 8; ++j) { v[j] = xr[64 * j]; s += (v[j].x * v[j].x + v[j].y * v[j].y) + (v[j].z * v[j].z + v[j].w * v[j].w); }
    const float r = 1.0f / sqrtf(wave_sum(s) * (1.0f / 2048.0f) + EPS_);
    v2u* o8 = (v2u*)orow + lane;
#pragma unroll
    for (int j = 0; j < 8; ++j) { const f32x4 g = gr[64 * j]; v2u w; w.x = pk2(v[j].x * r * g.x, v[j].y * r * g.y); w.y = pk2(v[j].z * r * g.z, v[j].w * r * g.w); o8[64 * j] = w; }
}
__device__ __forceinline__ void headnorm(bf16* X, int rows, int W, int HD, const float* gain, float scale, int gtid, int NT) {
    const int cpr = W / 8; const long total = (long)rows * cpr;
    for (long base = gtid; base < total; base += 4l * NT) {
        v4u v[4];
#pragma unroll
        for (int k = 0; k < 4; ++k) { const long idx = base + (long)k * NT; if (idx < total) v[k] = *(const v4u*)(X + idx * 8); }
#pragma unroll
        for (int k = 0; k < 4; ++k) { const long idx = base + (long)k * NT; if (idx < total) { const int ch = (int)(idx % cpr);
            float f[8] = {pg8::bf_lo(v[k].x), pg8::bf_hi(v[k].x), pg8::bf_lo(v[k].y), pg8::bf_hi(v[k].y), pg8::bf_lo(v[k].z), pg8::bf_hi(v[k].z), pg8::bf_lo(v[k].w), pg8::bf_hi(v[k].w)};
            float ss = 0.f;
#pragma unroll
            for (int j = 0; j < 8; ++j) ss += f[j] * f[j];
            ss += __shfl_xor(ss, 1); ss += __shfl_xor(ss, 2); ss += __shfl_xor(ss, 4); if (HD == 128) ss += __shfl_xor(ss, 8);
            const float r = scale / sqrtf(ss / (float)HD + EPS_);
            const float* g = gain + ((ch * 8) % HD);
            v4u o; o.x = pk2(f[0] * r * g[0], f[1] * r * g[1]); o.y = pk2(f[2] * r * g[2], f[3] * r * g[3]); o.z = pk2(f[4] * r * g[4], f[5] * r * g[5]); o.w = pk2(f[6] * r * g[6], f[7] * r * g[7]);
            *(v4u*)(X + idx * 8) = o; } } }
}

#define XB_TMO      128
#define XB_XCNT(j)  (256  + 64 * (j))
#define XB_XSUB(j)  (1280 + 64 * (j))
#define XB_XGEN(j)  (2304 + 64 * (j))
#define XB_TOP      3328
#define XB_TOPGEN   3392
#define XCD_BAR_WORDS 3456
#define XB_SPIN_CAP (1u << 18)

__device__ __forceinline__ unsigned xb_ld(unsigned* p)              { return __hip_atomic_load(p, __ATOMIC_RELAXED, __HIP_MEMORY_SCOPE_AGENT); }
__device__ __forceinline__ unsigned xb_add(unsigned* p, unsigned v) { return __hip_atomic_fetch_add(p, v, __ATOMIC_RELAXED, __HIP_MEMORY_SCOPE_AGENT); }
__device__ __forceinline__ unsigned xb_xcc_id() { return (unsigned)__builtin_amdgcn_s_getreg((3 << 11) | 20) & 0xFu; }
#define XB_SPIN(cond, bar) do { unsigned _sp = 0; while (cond) { __builtin_amdgcn_s_sleep(1); \
    if ((++_sp & 255u) == 0u) { if (xb_ld(&(bar)[XB_TMO])) break; if (_sp > XB_SPIN_CAP) { atomicAdd(&(bar)[XB_TMO], 1u); break; } } } } while (0)

struct XcdBarrier {
    unsigned* bar; unsigned x;
    volatile LAS unsigned* st;
};

__device__ __forceinline__ XcdBarrier xcd_barrier_post(unsigned* bar, volatile LAS unsigned* st) {
    XcdBarrier b; b.bar = bar; b.x = xb_xcc_id(); b.st = st;
    if (threadIdx.x == 0) (void)xb_add(&bar[XB_XCNT(b.x)], 1u);
    return b;
}
__device__ __forceinline__ void xcd_barrier_complete(unsigned* bar, unsigned x, unsigned& nloc, unsigned& nx) {
    const unsigned G = gridDim.x * gridDim.y * gridDim.z;
    unsigned sum, cnt, mine, sp = 0u;
    for (;;) {
        sum = 0u; cnt = 0u; mine = 0u;
#pragma unroll
        for (unsigned j = 0; j < 16; ++j) { const unsigned c = xb_ld(&bar[XB_XCNT(j)]); sum += c; cnt += (c > 0u) ? 1u : 0u; mine = (j == x) ? c : mine; }
        if (sum == G) break;
        __builtin_amdgcn_s_sleep(1);
        if ((++sp & 255u) == 0u) { if (xb_ld(&bar[XB_TMO])) break; if (sp > XB_SPIN_CAP) { atomicAdd(&bar[XB_TMO], 1u); break; } }
    }
    nloc = mine > 0u ? mine : 1u; nx = cnt > 0u ? cnt : 1u;
}

__device__ __forceinline__ void xcd_barrier(const XcdBarrier& b) {
    asm volatile("s_waitcnt vmcnt(0)" ::: "memory");
    __syncthreads();
    if (threadIdx.x == 0) {
        unsigned* bar = b.bar;
        __builtin_amdgcn_s_waitcnt(0);
        unsigned nloc = b.st[0], nx = b.st[1];
        if (nloc == 0u) { xcd_barrier_complete(bar, b.x, nloc, nx); b.st[0] = nloc; b.st[1] = nx; }
        const unsigned old = xb_add(&bar[XB_XSUB(b.x)], 1u);
        const unsigned gen = old / nloc;
        if (old + 1u == (gen + 1u) * nloc) {
            __builtin_amdgcn_fence(__ATOMIC_RELEASE, "agent");
            asm volatile("s_waitcnt vmcnt(0)" ::: "memory");
            const unsigned og = xb_add(&bar[XB_TOP], 1u);
            const unsigned tg = og / nx;
            if (og + 1u == (tg + 1u) * nx) xb_add(&bar[XB_TOPGEN], 1u);
            else XB_SPIN(xb_ld(&bar[XB_TOPGEN]) == tg, bar);
            __builtin_amdgcn_fence(__ATOMIC_ACQUIRE, "agent");
            xb_add(&bar[XB_XGEN(b.x)], 1u);
            asm volatile("s_waitcnt vmcnt(0)" ::: "memory");
        } else {
            XB_SPIN(xb_ld(&bar[XB_XGEN(b.x)]) == gen, bar);
            __builtin_amdgcn_fence(__ATOMIC_ACQUIRE, "agent");
            asm volatile("s_waitcnt vmcnt(0)" ::: "memory");
        }
    }
    __syncthreads();
}

struct Args { const float* in[23]; float* out; unsigned char* ws; int ph_lo, ph_hi; };

__global__ void __launch_bounds__(NWAVES * 64, 2) mk_fwd(Args args) {
    __builtin_assume(__builtin_amdgcn_workitem_id_y() == 0); __builtin_assume(__builtin_amdgcn_workitem_id_z() == 0);
    extern __shared__ __attribute__((aligned(16))) unsigned char lds[];
    LAS unsigned char* L = (LAS unsigned char*)lds;
    const int tid = threadIdx.x, lane = tid & 63, wave = __builtin_amdgcn_readfirstlane(tid >> 6);
    const int G = gridDim.x, bx = blockIdx.x, vcu = (G % 8 == 0) ? (bx % 8) * (G / 8) + bx / 8 : bx;
    const int gw = vcu * NWAVES + wave, NGW = G * NWAVES, gtid = gw * 64 + lane, NT = NGW * 64;
    unsigned char* ws = args.ws;
    if (tid < 16) ((LAS unsigned*)(L + LDS_BYTES - 64))[tid] = 0u;
    __syncthreads();
    const XcdBarrier gbar = xcd_barrier_post((unsigned*)(ws + WS_BAR), (volatile LAS unsigned*)(L + LDS_BYTES - 64));
    LAS float* scr = (LAS float*)(L + wave * TSCR);

    const int lo = args.ph_lo, hi = args.ph_hi;
#define IN(k) (lo <= (k) && (k) < hi)
#define SEAM(k) do { if ((k) + 1 < hi) { xcd_barrier(gbar); } } while (0)
#define GEMM(EPI, g, E, crot) do { pg8::StaticOrder S_; S_.init((g).M, (g).N, G, (bx + (crot)) % G); pg8::gemm_phase<EPI, pg8::StaticOrder, true, true>(L, g, S_, E); } while (0)

    if (IN(0)) {
        const int i0 = transpose_items(2048, 11264), i1 = transpose_items(5632, 2048), i2 = transpose_items(2048, NWIN_SRC), i3 = transpose_items(1024, 2048), i4 = transpose_items(2048, 1024),
                  i5 = transpose_items(512, 2048), i6 = transpose_items(2048, 2048);
        const int total = i0 + i1 + i2 + i3 + i4 + i5 + i6;
        for (int it = gw; it < total; it += NGW) { int r = it;
            if (r < i0) { transpose_item(args.in[3], 2048, 11264, (bf16*)(ws + WS_GU), 1, scr, r, lane); continue; } r -= i0;
            if (r < i1) { transpose_item(args.in[4], 5632, 2048, (bf16*)(ws + WS_DN), 0, scr, r, lane); continue; } r -= i1;
            if (r < i2) { transpose_item(args.in[7], 2048, NWIN_SRC, (bf16*)(ws + WS_WIN), 2, scr, r, lane, 0, 0, args.in[5]); continue; } r -= i2;
            if (r < i3) { transpose_item(args.in[14], 1024, 2048, (bf16*)(ws + WS_WCAT), 0, scr, r, lane, 2048, 512); continue; } r -= i3;
            if (r < i4) { transpose_item(args.in[15], 2048, 1024, (bf16*)(ws + WS_WMKV), 0, scr, r, lane); continue; } r -= i4;
            if (r < i5) { transpose_item(args.in[18], 512, 2048, (bf16*)(ws + WS_WCAT), 0, scr, r, lane, 2048, 1536); continue; } r -= i5;
            transpose_item(args.in[19], 2048, 2048, (bf16*)(ws + WS_WO), 0, scr, r, lane); }
        for (int i = gtid; i < 2 * M_; i += NT) { ((float*)(ws + WS_SSQ1))[i < M_ ? i : i - M_ + (int)((WS_SSQ2 - WS_SSQ1) / 4)] = 0.f; }
        for (int i = gtid; i < 240 * 256; i += NT) *(v4u*)(ws + WS_WIN + (size_t)10256 * 4096 + (size_t)i * 16) = (v4u){0u, 0u, 0u, 0u};
        { const float* pw = args.in[9]; const float* ps = args.in[10]; const float* wpu = args.in[11]; bf16* WP = (bf16*)(ws + WS_WCAT);
          for (int it = gw; it < 2048; it += NGW) { const int nb = it >> 6, cc = it & 63, g = cc >> 4, c0 = (cc & 15) * 8, n = nb * 64 + lane;
            float a0 = 0.f, a1 = 0.f, a2 = 0.f, a3 = 0.f, a4 = 0.f, a5 = 0.f, a6 = 0.f, a7 = 0.f;
            const float* pr = pw + (size_t)(g * 128 + c0) * 128;
#pragma unroll 16
            for (int d = 0; d < 128; ++d) { const float wv = ps[g * 128 + d] * wpu[(size_t)(g * 128 + d) * 2048 + n];
                a0 += pr[d] * wv; a1 += pr[128 + d] * wv; a2 += pr[256 + d] * wv; a3 += pr[384 + d] * wv; a4 += pr[512 + d] * wv; a5 += pr[640 + d] * wv; a6 += pr[768 + d] * wv; a7 += pr[896 + d] * wv; }
            v4u o; o.x = pk2(a0, a1); o.y = pk2(a2, a3); o.z = pk2(a4, a5); o.w = pk2(a6, a7);
            *(v4u*)(WP + (size_t)n * 2048 + cc * 8) = o; } }
        for (int m = gw; m < M_; m += NGW) norm_row(args.in[0] + (size_t)m * 2048, args.in[2], (bf16*)(ws + WS_H) + (size_t)m * 2048, lane);
        for (int m = gw; m < MM_; m += NGW) norm_row(args.in[1] + (size_t)m * 2048, args.in[6], (bf16*)(ws + WS_MEMN) + (size_t)m * 2048, lane);
        SEAM(0);
    }
    if (IN(1)) {
        __syncthreads();
        { const pg8::Gemm g{(const bf16*)(ws + WS_H), (const bf16*)(ws + WS_GU), M_, 2 * FF_, 2048}; const pg8::EpiSwiGLU E{(bf16*)(ws + WS_BIG), FF_, nullptr}; GEMM(pg8::EpiSwiGLU, g, E, 0); }
        SEAM(1);
    }
    if (IN(2)) {
        __syncthreads();
        { const pg8::Gemm g{(const bf16*)(ws + WS_BIG), (const bf16*)(ws + WS_DN), M_, 2048, FF_}; const pg8::EpiResid E{args.in[0], nullptr, nullptr, (bf16*)(ws + WS_H), (float*)(ws + WS_SSQ1), 2048, 0.5f}; GEMM(pg8::EpiResid, g, E, 0); }
        SEAM(2);
    }
    if (IN(4)) {
        __syncthreads();
        { const pg8::Gemm g{(const bf16*)(ws + WS_H), (const bf16*)(ws + WS_WIN), M_, NWIN, 2048};
          const pg8::EpiWin E{(bf16*)(ws + WS_UP), (bf16*)(ws + WS_QF), (bf16*)(ws + WS_KF), (bf16*)(ws + WS_VF), (bf16*)(ws + WS_QM), (bf16*)(ws + WS_GATE), (float*)(ws + WS_LOGF), args.in[8], (const float*)(ws + WS_SSQ1), args.in[12], args.in[13], args.in[16], (LAS float*)(L + RING_BYTES)};
          GEMM(pg8::EpiWin, g, E, 0); }
        { const pg8::Gemm g{(const bf16*)(ws + WS_MEMN), (const bf16*)(ws + WS_WMKV), MM_, 512, 2048}; const pg8::EpiBf16<0> E{(bf16*)(ws + WS_KM), 512, nullptr, 0, 0, 1.f}; GEMM(pg8::EpiBf16<0>, g, E, G / 2); }
        { const pg8::Gemm g{(const bf16*)(ws + WS_WMKV) + (size_t)512 * 2048, (const bf16*)(ws + WS_MEMN), 512, MM_, 2048}; const pg8::EpiBf16<0> E{(bf16*)(ws + WS_VT), MM_, nullptr, 0, 0, 1.f}; GEMM(pg8::EpiBf16<0>, g, E, (3 * G) / 8); }
        if (bx >= (3 * G) / 4) { const int gw2 = (bx - (3 * G) / 4) * NWAVES + wave, NGW2 = (G - (3 * G) / 4) * NWAVES;
          const int i0 = transpose_items(2048, 11264), i1 = transpose_items(5632, 2048);
          for (int it = gw2; it < i0 + i1; it += NGW2) {
            if (it < i0) transpose_item(args.in[21], 2048, 11264, (bf16*)(ws + WS_GU), 1, scr, it, lane, 0, 0, args.in[20]);
            else transpose_item(args.in[22], 5632, 2048, (bf16*)(ws + WS_DN), 0, scr, it - i0, lane); } }
        SEAM(4);
    }
    if (IN(6)) {
        { const bf16* UP = (const bf16*)(ws + WS_UP); bf16* PD = (bf16*)args.out;
          for (int it = gtid; it < (M_ / 8) * 64; it += NT) { const int cc = it & 63, m0 = (it >> 6) * 8, t0 = m0 & (S_ - 1), w = 2 << (cc >> 4);
            const bf16* up = UP + (size_t)m0 * 512 + cc * 8;
            v4u hv[15], cv[8];
#pragma unroll
            for (int j = 0; j < 15; ++j) { hv[j] = (v4u){0u, 0u, 0u, 0u}; if (j + 1 < w && t0 >= j + 1) hv[j] = *(const v4u*)(up - (size_t)(j + 1) * 512); }
#pragma unroll
            for (int r = 0; r < 8; ++r) cv[r] = *(const v4u*)(up + (size_t)r * 512);
#pragma unroll
            for (int r = 0; r < 8; ++r) { float s0 = 0.f, s1 = 0.f, s2 = 0.f, s3 = 0.f, s4 = 0.f, s5 = 0.f, s6 = 0.f, s7 = 0.f;
#pragma unroll
                for (int j = 0; j < 16; ++j) { if (j <= r + 15) { const v4u v = (r - j >= 0) ? cv[(r - j >= 0) ? r - j : 0] : hv[(j - r - 1 >= 0 && j - r - 1 < 15) ? j - r - 1 : 0];
                    if (j < w) { s0 += pg8::bf_lo(v.x); s1 += pg8::bf_hi(v.x); s2 += pg8::bf_lo(v.y); s3 += pg8::bf_hi(v.y); s4 += pg8::bf_lo(v.z); s5 += pg8::bf_hi(v.z); s6 += pg8::bf_lo(v.w); s7 += pg8::bf_hi(v.w); } } }
                const int tt = t0 + r + 1; const float rn = 1.0f / (float)(tt < w ? tt : w); const v4u c = cv[r];
                v4u o; o.x = pk2(s0 * rn - pg8::bf_lo(c.x), s1 * rn - pg8::bf_hi(c.x)); o.y = pk2(s2 * rn - pg8::bf_lo(c.y), s3 * rn - pg8::bf_hi(c.y));
                o.z = pk2(s4 * rn - pg8::bf_lo(c.z), s5 * rn - pg8::bf_hi(c.z)); o.w = pk2(s6 * rn - pg8::bf_lo(c.w), s7 * rn - pg8::bf_hi(c.w));
                *(v4u*)(PD + (size_t)(m0 + r) * 2048 + cc * 8) = o; } } }
        __syncthreads();
        { const attn_body::AttnTensors AT{(const attn_body::bf16*)(ws + WS_QF), (const attn_body::bf16*)(ws + WS_KF), (const attn_body::bf16*)(ws + WS_VF), (attn_body::bf16*)args.out + 512, (const float*)(ws + WS_LOGF)};
          const attn_body::StaticOrder S(G, vcu);
          attn_body::attn_phase<attn_body::StaticOrder, 40>((char*)lds, AT, S); }
        __syncthreads();
        for (int p = vcu; p < B_ * 4 * 4; p += G) { const int b = p >> 4, hm = (p >> 2) & 3;
            memattn::stage_kv(b, hm, (const bf16*)(ws + WS_KM), (const bf16*)(ws + WS_VT), args.in[17], L);
            __syncthreads();
            memattn::unit(b, hm, (p & 3) * 2, (const bf16*)(ws + WS_QM), (bf16*)args.out + 1536, L);
            memattn::unit(b, hm, (p & 3) * 2 + 1, (const bf16*)(ws + WS_QM), (bf16*)args.out + 1536, L);
            __syncthreads(); }
        SEAM(6);
    }
    if (IN(7)) {
        __syncthreads();
        { const pg8::Gemm g{(const bf16*)args.out, (const bf16*)(ws + WS_WCAT), M_, 2048, 2048}; const pg8::EpiGate E{(bf16*)(ws + WS_QF), (const bf16*)(ws + WS_GATE)}; GEMM(pg8::EpiGate, g, E, 0); }
        SEAM(7);
    }
    if (IN(8)) {
        __syncthreads();
        { const pg8::Gemm g{(const bf16*)(ws + WS_QF), (const bf16*)(ws + WS_WO), M_, 2048, 2048}; const pg8::EpiResid E{nullptr, (const bf16*)(ws + WS_H), nullptr, (bf16*)(ws + WS_H3), (float*)(ws + WS_SSQ2), 2048, 1.0f}; GEMM(pg8::EpiResid, g, E, 0); }
        SEAM(8);
    }
    if (IN(10)) {
        __syncthreads();
        { const pg8::Gemm g{(const bf16*)(ws + WS_H3), (const bf16*)(ws + WS_GU), M_, 2 * FF_, 2048}; const pg8::EpiSwiGLU E{(bf16*)(ws + WS_BIG), FF_, (const float*)(ws + WS_SSQ2)}; GEMM(pg8::EpiSwiGLU, g, E, 0); }
        SEAM(10);
    }
    if (IN(11)) {
        __syncthreads();
        { const pg8::Gemm g{(const bf16*)(ws + WS_BIG), (const bf16*)(ws + WS_DN), M_, 2048, FF_}; const pg8::EpiResid E{nullptr, (const bf16*)(ws + WS_H3), args.out, nullptr, nullptr, 2048, 0.5f}; GEMM(pg8::EpiResid, g, E, 0); }
    }
    if (hi > 4096) cg::this_grid().sync();
#undef IN
#undef SEAM
#undef GEMM
}

extern "C" void kernel_launch(void* const* d_in, const int* in_sizes, int n_in, void* d_out, int out_size, void* d_ws, size_t ws_size, hipStream_t stream) {
    static int grid = 0;
    if (grid == 0) {
        if (n_in != 23 || in_sizes[0] != M_ * DM_ || out_size != M_ * DM_ || ws_size < WS_END) { fprintf(stderr, "kernel_launch: unexpected problem (n_in %d, ws %zu < %zu?); nothing launched\n", n_in, ws_size, (size_t)WS_END); grid = -1; return; }
        int dev = 0, cus = 0, per_cu = 0;
        if (hipGetDevice(&dev) != hipSuccess || hipDeviceGetAttribute(&cus, hipDeviceAttributeMultiprocessorCount, dev) != hipSuccess) { grid = -1; return; }
        if (hipFuncSetAttribute((const void*)mk_fwd, hipFuncAttributeMaxDynamicSharedMemorySize, LDS_BYTES) != hipSuccess) { fprintf(stderr, "kernel_launch: hipFuncSetAttribute failed\n"); grid = -1; return; }
        if (hipOccupancyMaxActiveBlocksPerMultiprocessor(&per_cu, (const void*)mk_fwd, NWAVES * 64, LDS_BYTES) != hipSuccess || per_cu < 1) { fprintf(stderr, "kernel_launch: occupancy query says %d\n", per_cu); per_cu = 1; }
        (void)hipGetLastError();
        grid = cus * per_cu;
    }
    if (grid < 0) return;
    (void)hipMemsetAsync((unsigned char*)d_ws + WS_BAR, 0, WS_BAR_BYTES, stream);
    Args a{};
    for (int i = 0; i < 23; ++i) a.in[i] = (const float*)d_in[i];
    a.out = (float*)d_out; a.ws = (unsigned char*)d_ws;
#if MK_N_LAUNCHES == 1
    a.ph_lo = 0; a.ph_hi = NPH;
    void* kargs[] = {&a};
    hipError_t e = hipLaunchCooperativeKernel((const void*)mk_fwd, dim3(grid), dim3(NWAVES * 64), kargs, LDS_BYTES, stream);
    if (e != hipSuccess) fprintf(stderr, "kernel_launch: cooperative launch failed: %s (grid %d)\n", hipGetErrorString(e), grid);
#elif MK_N_LAUNCHES == 112
    for (int ph = 0; ph < NPH; ++ph) { a.ph_lo = ph; a.ph_hi = ph + 1; void* kargs[] = {&a}; (void)hipLaunchCooperativeKernel((const void*)mk_fwd, dim3(grid), dim3(NWAVES * 64), kargs, LDS_BYTES, stream); }
#else
    for (int ph = 0; ph < NPH; ++ph) { a.ph_lo = ph; a.ph_hi = ph + 1; for (int rep = 0; rep < (((PROBE_DOUBLE_MASK) >> ph) & 1) + 1; ++rep) hipLaunchKernelGGL(mk_fwd, dim3(grid), dim3(NWAVES * 64), LDS_BYTES, stream, a); }
#endif
}
```

```cpp
#define MK_N_LAUNCHES 1
#include <hip/hip_runtime.h>
#include <hip/hip_cooperative_groups.h>
namespace cg = cooperative_groups;
#include <hip/hip_runtime.h>
#include <cstdio>
#include <cstdint>
namespace pg8 {
#define PG8_LAS __attribute__((address_space(3)))
typedef unsigned short bf16_t;
typedef short bf16x8 __attribute__((ext_vector_type(8)));
typedef float f32x4 __attribute__((ext_vector_type(4)));
typedef unsigned u32x4 __attribute__((ext_vector_type(4)));
constexpr int BM = 256, BK = 64, HALF = 128, HTB = HALF * BK * 2  , STAGE_BYTES = 8 * HTB, NXCD = 8, WGM = 8;

__host__ __device__ __forceinline__ int lds_byte(int r, int c) { const int st = (r >> 4) * 2 + (c >> 5), rr = r & 15, cc = c & 31, ob = rr * 64 + cc * 2; return st * 1024 + (ob ^ (((ob >> 9) & 1) << 5)); }
__host__ __device__ __forceinline__ void stage_rc(int b, int& R, int& C) { const int st = b / 1024, sb = b % 1024, swz = sb ^ (((sb >> 9) & 1) << 5); R = (st >> 1) * 16 + swz / 64; C = (st & 1) * 32 + (swz % 64) / 2; }
__host__ __device__ __forceinline__ int perm32(int rho) { const int n = rho >> 4, i = rho & 15; return 8 * (i >> 2) + 4 * n + (i & 3); }

struct Unit { int pm, pn; };
struct Gemm { const bf16_t* A; const bf16_t* Bt; int M, N, K; };

struct StaticOrder {
    int nM, nN, nwg, G, c;
    __host__ __device__ void init(int M, int N, int G_, int c_) { nM = M / BM; nN = N / BM; nwg = nM * nN; G = G_; c = c_; }
    __host__ __device__ bool next(int i, Unit& u) const {
        const long L = (long)i * G + c; if (L >= nwg) return false;
        int wgid = (int)L; { const int q = nwg / NXCD, r = nwg % NXCD, xcd = wgid % NXCD, off = wgid / NXCD; wgid = (xcd < r ? xcd * (q + 1) : r * (q + 1) + (xcd - r) * q) + off; }
        const int nig = WGM * nN, gid = wgid / nig, fm = gid * WGM, gsz = (nM - fm) < WGM ? (nM - fm) : WGM;
        u.pm = fm + ((wgid % nig) % gsz); u.pn = (wgid % nig) / gsz; return true;
    }
    __device__ __forceinline__ void a_ready(const Unit&) const {}
    __device__ __forceinline__ void done(const Unit&) const {}
};

__device__ __forceinline__ unsigned cvt_pk_bf16(float lo, float hi) { unsigned r; asm volatile("v_cvt_pk_bf16_f32 %0, %1, %2" : "=v"(r) : "v"(lo), "v"(hi)); return r; }
typedef float f32x2 __attribute__((ext_vector_type(2)));
__device__ __forceinline__ f32x2 gelu_pk(f32x2 v) {
    const f32x2 av = __builtin_elementwise_abs(v), d = av * 0.2316418882f + 1.0f;
    f32x2 t; t.x = __builtin_amdgcn_rcpf(d.x); t.y = __builtin_amdgcn_rcpf(d.y);
    f32x2 q = t * 0.5307027145f + (-0.7265760135f); q = q * t + 0.7107068705f; q = q * t + (-0.142248368f); q = q * t + 0.127414796f; q = q * t;
    const f32x2 s = (v * v) * (-0.72134752044f);
    f32x2 e; e.x = __builtin_amdgcn_exp2f(s.x); e.y = __builtin_amdgcn_exp2f(s.y);
    const f32x2 m = v * (q * e), r = v - m;
    f32x2 o; o.x = v.x < 0.f ? m.x : r.x; o.y = v.y < 0.f ? m.y : r.y; return o;
}

template <int ACT  > struct EpiBf16 {
    static constexpr bool PERM = true, AFTER_DRAIN = false, HOOK = false, CTX = false; static constexpr int H1 = -1, H2 = -1; static_assert(ACT == 0 || ACT == 1, "EpiBf16: ACT is 0 (none) or 1 (gelu_pk)");
    bf16_t* O; int ldc; const float* bias; int split_cols; size_t split_stride; float scale0;
    __device__ __forceinline__ void operator()(const f32x4 (&acc)[2][2][4][2], const Unit& u, int wr, int wc, int fr, int fq) const {
        const int row0 = u.pm * BM + wr * 64 + fr; int colt = u.pn * BM; bf16_t* base = O;
        float sc = 1.f; if (split_cols) { const int t = colt / split_cols; base += (size_t)t * split_stride; colt -= t * split_cols; if (t == 0) sc = scale0; }
        const int col0 = colt + wc * 32 + 8 * fq, bcol0 = u.pn * BM + wc * 32 + 8 * fq;
        f32x4 bv[2][2];
#pragma unroll
        for (int bj = 0; bj < 2; ++bj)
#pragma unroll
            for (int n = 0; n < 2; ++n) bv[bj][n] = bias ? *(const f32x4*)(bias + bcol0 + bj * HALF + 4 * n) : (f32x4){0.f, 0.f, 0.f, 0.f};
#pragma unroll
        for (int ai = 0; ai < 2; ++ai)
#pragma unroll
            for (int m = 0; m < 4; ++m) { bf16_t* rowp = base + (size_t)(row0 + ai * HALF + m * 16) * ldc + col0;
#pragma unroll
                for (int bj = 0; bj < 2; ++bj) { f32x4 v0 = acc[ai][bj][m][0] + bv[bj][0], v1 = acc[ai][bj][m][1] + bv[bj][1];
                    if (ACT == 1) { f32x2 a = gelu_pk((f32x2){v0[0], v0[1]}), b = gelu_pk((f32x2){v0[2], v0[3]}), c = gelu_pk((f32x2){v1[0], v1[1]}), d = gelu_pk((f32x2){v1[2], v1[3]});
                        v0 = (f32x4){a.x, a.y, b.x, b.y}; v1 = (f32x4){c.x, c.y, d.x, d.y}; }
                    v0 = v0 * sc; v1 = v1 * sc; u32x4 w; w.x = cvt_pk_bf16(v0[0], v0[1]); w.y = cvt_pk_bf16(v0[2], v0[3]); w.z = cvt_pk_bf16(v1[0], v1[1]); w.w = cvt_pk_bf16(v1[2], v1[3]);
                    *(u32x4*)(rowp + bj * HALF) = w; } }
    }
};
__device__ __forceinline__ float sigm_f(float g) { return __builtin_amdgcn_rcpf(1.0f + __builtin_amdgcn_exp2f(-1.4426950408889634f * g)); }
__device__ __forceinline__ float silu_f(float g) { return g * sigm_f(g); }
__device__ __forceinline__ float sigm2_f(float x) { return __builtin_amdgcn_rcpf(1.0f + __builtin_amdgcn_exp2f(-x)); }
__device__ __forceinline__ float gate_f(float x) { return fmaxf(sigm2_f(x), 1e-18f); }
__device__ __forceinline__ float bf_lo(unsigned w) { return __uint_as_float(w << 16); }
__device__ __forceinline__ float bf_hi(unsigned w) { return __uint_as_float(w & 0xffff0000u); }
__device__ __forceinline__ float logsig_f(float x) { return fminf(x, 0.f) - 0.6931471805599453f * __builtin_amdgcn_logf(1.0f + __builtin_amdgcn_exp2f(-1.4426950408889634f * fabsf(x))); }

struct EpiSwiGLU {
    static constexpr bool PERM = true, AFTER_DRAIN = false, HOOK = false, CTX = true;
    bf16_t* O; int ldc; const float* ssq;
    __device__ __forceinline__ void run(const f32x4 (&acc)[2][2][4][2], const Unit& u, int wr, int wc, int fr, int fq, float (&rc)[8], int& cpm) const {
        const int row0 = u.pm * BM + wr * 64 + fr, col0 = u.pn * HALF + wc * 32 + 8 * fq;
        if (ssq && u.pm != cpm) { cpm = u.pm;
#pragma unroll
            for (int k = 0; k < 8; ++k) rc[k] = 1.0f / sqrtf(ssq[row0 + (k >> 2) * HALF + (k & 3) * 16] * (1.0f / 2048.0f) + 1e-6f); }
#pragma unroll
        for (int ai = 0; ai < 2; ++ai)
#pragma unroll
            for (int m = 0; m < 4; ++m) { bf16_t* p = O + (size_t)(row0 + ai * HALF + m * 16) * ldc + col0;
                const float rs = rc[ai * 4 + m];
                const f32x4 g0 = acc[ai][0][m][0] * rs, g1 = acc[ai][0][m][1] * rs, u0 = acc[ai][1][m][0] * rs, u1 = acc[ai][1][m][1] * rs;
                u32x4 w; w.x = cvt_pk_bf16(g0[0] * sigm2_f(g0[0]) * u0[0], g0[1] * sigm2_f(g0[1]) * u0[1]); w.y = cvt_pk_bf16(g0[2] * sigm2_f(g0[2]) * u0[2], g0[3] * sigm2_f(g0[3]) * u0[3]);
                w.z = cvt_pk_bf16(g1[0] * sigm2_f(g1[0]) * u1[0], g1[1] * sigm2_f(g1[1]) * u1[1]); w.w = cvt_pk_bf16(g1[2] * sigm2_f(g1[2]) * u1[2], g1[3] * sigm2_f(g1[3]) * u1[3]);
                *(u32x4*)p = w; }
    }
};
struct EpiResid {
    static constexpr bool PERM = true, AFTER_DRAIN = false, HOOK = false, CTX = false; static constexpr int H1 = -1, H2 = -1;
    const float* basef; const bf16_t* baseb; float* outf; bf16_t* outb; float* ssq; int ldc; float alpha;
    __device__ __forceinline__ void operator()(const f32x4 (&acc)[2][2][4][2], const Unit& u, int wr, int wc, int fr, int fq) const {
        const int col0 = u.pn * BM + wc * 32 + 8 * fq;
#pragma unroll
        for (int ai = 0; ai < 2; ++ai) {
            f32x4 bf0[4][2], bf1[4][2]; u32x4 bq[4][2]; float keep = 0.f;
#pragma unroll
            for (int m = 0; m < 4; ++m)
#pragma unroll
                for (int bj = 0; bj < 2; ++bj) { const size_t idx = (size_t)(u.pm * BM + ai * HALF + wr * 64 + m * 16 + fr) * ldc + col0 + bj * HALF;
                    if (basef) { bf0[m][bj] = *(const f32x4*)(basef + idx); bf1[m][bj] = *(const f32x4*)(basef + idx + 4); } else bq[m][bj] = *(const u32x4*)(baseb + idx); }
#pragma unroll
            for (int m = 0; m < 4; ++m) { const int row = u.pm * BM + ai * HALF + wr * 64 + m * 16 + fr; const size_t off = (size_t)row * ldc + col0; float ss = 0.f;
#pragma unroll
                for (int bj = 0; bj < 2; ++bj) { const size_t idx = off + bj * HALF; f32x4 b0, b1;
                    if (basef) { b0 = bf0[m][bj]; b1 = bf1[m][bj]; }
                    else { const u32x4 q = bq[m][bj]; b0 = (f32x4){bf_lo(q.x), bf_hi(q.x), bf_lo(q.y), bf_hi(q.y)}; b1 = (f32x4){bf_lo(q.z), bf_hi(q.z), bf_lo(q.w), bf_hi(q.w)}; }
                    const f32x4 v0 = b0 + acc[ai][bj][m][0] * alpha, v1 = b1 + acc[ai][bj][m][1] * alpha;
                    if (outf) { *(f32x4*)(outf + idx) = v0; *(f32x4*)(outf + idx + 4) = v1; }
                    if (outb) { u32x4 w; w.x = cvt_pk_bf16(v0[0], v0[1]); w.y = cvt_pk_bf16(v0[2], v0[3]); w.z = cvt_pk_bf16(v1[0], v1[1]); w.w = cvt_pk_bf16(v1[2], v1[3]); *(u32x4*)(outb + idx) = w; }
                    ss += ((v0[0] * v0[0] + v0[1] * v0[1]) + (v0[2] * v0[2] + v0[3] * v0[3])) + ((v1[0] * v1[0] + v1[1] * v1[1]) + (v1[2] * v1[2] + v1[3] * v1[3])); }
                if (ssq) { ss += __shfl_xor(ss, 16); ss += __shfl_xor(ss, 32); if (m == fq) keep = ss; } }
            if (ssq) (void)__hip_atomic_fetch_add(ssq + (u.pm * BM + ai * HALF + wr * 64 + fq * 16 + fr), keep, __ATOMIC_RELAXED, __HIP_MEMORY_SCOPE_AGENT); }
    }
};
struct EpiWin {
    static constexpr bool PERM = true, AFTER_DRAIN = false, HOOK = false, CTX = true; static constexpr int H1 = -1, H2 = -1;
    bf16_t *UP, *QF, *KF, *VF, *QM, *GATE; float* LOGF; const float* bfg; const float* ssq; const float *gq, *gk, *gm; PG8_LAS float* X;
    __device__ __forceinline__ void run(const f32x4 (&acc)[2][2][4][2], const Unit& u, int wr, int wc, int fr, int fq, float (&rc)[8], int& cpm) const {
        const int pn = u.pn, row0 = u.pm * BM + wr * 64 + fr;
        if (u.pm != cpm) { cpm = u.pm;
#pragma unroll
            for (int k = 0; k < 8; ++k) rc[k] = 1.0f / sqrtf(ssq[row0 + (k >> 2) * HALF + (k & 3) * 16] * (1.0f / 2048.0f) + 1e-6f); }
        if (pn == 40) {
            if (wc == 0 && fq < 2) {
                const f32x4 b0 = *(const f32x4*)(bfg + 8 * fq), b1 = *(const f32x4*)(bfg + 8 * fq + 4);
#pragma unroll
                for (int ai = 0; ai < 2; ++ai)
#pragma unroll
                    for (int m = 0; m < 4; ++m) { float* p = LOGF + (size_t)(row0 + ai * HALF + m * 16) * 16 + 8 * fq;
                        const float rs = rc[ai * 4 + m];
                        const f32x4 v0 = acc[ai][0][m][0] * rs + b0, v1 = acc[ai][0][m][1] * rs + b1;
                        *(f32x4*)p = (f32x4){logsig_f(v0[0]), logsig_f(v0[1]), logsig_f(v0[2]), logsig_f(v0[3])};
                        *(f32x4*)(p + 4) = (f32x4){logsig_f(v1[0]), logsig_f(v1[1]), logsig_f(v1[2]), logsig_f(v1[3])}; }
            }
            return;
        }
        bf16_t* O; int ldc, colt; bool sg = false; int hn = 0; const float* gain = nullptr; float hscale = 1.f;
        if (pn < 2) { O = UP; ldc = 512; colt = pn * BM; } else if (pn < 6) { O = QF; ldc = 1024; colt = (pn - 2) * BM; hn = 1; gain = gq; hscale = 0.125f * 1.4426950408889634f; }
        else if (pn < 10) { O = KF; ldc = 1024; colt = (pn - 6) * BM; hn = 1; gain = gk; }
        else if (pn < 14) { O = VF; ldc = 1024; colt = (pn - 10) * BM; } else if (pn < 16) { O = QM; ldc = 512; colt = (pn - 14) * BM; hn = 2; gain = gm; hscale = 0.08838834764831845f * 1.4426950408889634f; }
        else { O = GATE; ldc = 6144; colt = (pn - 16) * BM; sg = true; }
        const int col0 = colt + wc * 32 + 8 * fq;
        float rsv[2][4];
#pragma unroll
        for (int ai = 0; ai < 2; ++ai)
#pragma unroll
            for (int m = 0; m < 4; ++m) rsv[ai][m] = rc[ai * 4 + m];
        if (hn) {
#pragma unroll
            for (int ai = 0; ai < 2; ++ai)
#pragma unroll
                for (int m = 0; m < 4; ++m) { const int rowl = ai * HALF + wr * 64 + m * 16 + fr; const float rs = rsv[ai][m];
#pragma unroll
                    for (int bj = 0; bj < 2; ++bj) { const f32x4 v0 = acc[ai][bj][m][0] * rs, v1 = acc[ai][bj][m][1] * rs;
                        float s = (v0[0] * v0[0] + v0[1] * v0[1]) + (v0[2] * v0[2] + v0[3] * v0[3]) + (v1[0] * v1[0] + v1[1] * v1[1]) + (v1[2] * v1[2] + v1[3] * v1[3]);
                        s += __shfl_xor(s, 16); s += __shfl_xor(s, 32);
                        if (fq == 0) X[(rowl * 2 + bj) * 4 + wc] = s; } }
            asm volatile("s_waitcnt lgkmcnt(0)" ::: "memory"); __builtin_amdgcn_s_barrier(); asm volatile("" ::: "memory");
            const int d0 = (hn == 1 ? 32 * (wc & 1) : 32 * wc) + 8 * fq; const f32x4 g0 = *(const f32x4*)(gain + d0), g1 = *(const f32x4*)(gain + d0 + 4);
            const float ihd = hn == 1 ? (1.0f / 64.0f) : (1.0f / 128.0f);
#pragma unroll
            for (int ai = 0; ai < 2; ++ai)
#pragma unroll
                for (int m = 0; m < 4; ++m) { const int rowl = ai * HALF + wr * 64 + m * 16 + fr; bf16_t* rowp = O + (size_t)(row0 + ai * HALF + m * 16) * ldc + col0;
#pragma unroll
                    for (int bj = 0; bj < 2; ++bj) { const f32x4 xs = *(const PG8_LAS f32x4*)(X + (rowl * 2 + bj) * 4);
                        const float tot = hn == 1 ? ((wc & 2) ? xs[2] + xs[3] : xs[0] + xs[1]) : (xs[0] + xs[1]) + (xs[2] + xs[3]);
                        const float r = rsv[ai][m] * hscale / sqrtf(tot * ihd + 1e-6f);
                        const f32x4 v0 = acc[ai][bj][m][0] * r * g0, v1 = acc[ai][bj][m][1] * r * g1;
                        u32x4 w; w.x = cvt_pk_bf16(v0[0], v0[1]); w.y = cvt_pk_bf16(v0[2], v0[3]); w.z = cvt_pk_bf16(v1[0], v1[1]); w.w = cvt_pk_bf16(v1[2], v1[3]);
                        *(u32x4*)(rowp + bj * HALF) = w; } }
            return;
        }
#pragma unroll
        for (int ai = 0; ai < 2; ++ai)
#pragma unroll
            for (int m = 0; m < 4; ++m) { bf16_t* rowp = O + (size_t)(row0 + ai * HALF + m * 16) * ldc + col0; const float rs = rsv[ai][m];
#pragma unroll
                for (int bj = 0; bj < 2; ++bj) { f32x4 v0 = acc[ai][bj][m][0] * rs, v1 = acc[ai][bj][m][1] * rs;
                    if (sg) { v0 = (f32x4){gate_f(v0[0]), gate_f(v0[1]), gate_f(v0[2]), gate_f(v0[3])}; v1 = (f32x4){gate_f(v1[0]), gate_f(v1[1]), gate_f(v1[2]), gate_f(v1[3])}; }
                    u32x4 w; w.x = cvt_pk_bf16(v0[0], v0[1]); w.y = cvt_pk_bf16(v0[2], v0[3]); w.z = cvt_pk_bf16(v1[0], v1[1]); w.w = cvt_pk_bf16(v1[2], v1[3]);
                    *(u32x4*)(rowp + bj * HALF) = w; } }
    }
};
struct EpiGate {
    static constexpr bool PERM = true, AFTER_DRAIN = false, HOOK = true, CTX = false; static constexpr int H1 = 8, H2 = 24;
    bf16_t* MG; const bf16_t* G;
    __device__ __forceinline__ void hook(f32x4 (&acc)[2][2][4][2], const Unit& u, int t, int wr, int wc, int fr, int fq) const {
        asm volatile("" : "+v"(fr), "+v"(fq));
        const int row0 = u.pm * BM + wr * 64 + fr, col0 = u.pn * BM + wc * 32 + 8 * fq, gnum = (t == H1) ? 0 : 2048;
#pragma unroll
        for (int ai = 0; ai < 2; ++ai) {
            u32x4 ga[4][2], gb[4][2];
            asm volatile("" ::: "memory");
#pragma unroll
            for (int m = 0; m < 4; ++m) { const bf16_t* gp = G + (size_t)(row0 + ai * HALF + m * 16) * 6144 + gnum + col0;
#pragma unroll
                for (int bj = 0; bj < 2; ++bj) { ga[m][bj] = *(const u32x4*)(gp + bj * HALF); gb[m][bj] = *(const u32x4*)(gp + 2048 + bj * HALF); } }
#pragma unroll
            for (int m = 0; m < 4; ++m)
#pragma unroll
                for (int bj = 0; bj < 2; ++bj) { const u32x4 a = ga[m][bj], b = gb[m][bj];
                    const f32x4 r0 = (f32x4){bf_lo(a.x) * __builtin_amdgcn_rcpf(bf_lo(b.x)), bf_hi(a.x) * __builtin_amdgcn_rcpf(bf_hi(b.x)), bf_lo(a.y) * __builtin_amdgcn_rcpf(bf_lo(b.y)), bf_hi(a.y) * __builtin_amdgcn_rcpf(bf_hi(b.y))};
                    const f32x4 r1 = (f32x4){bf_lo(a.z) * __builtin_amdgcn_rcpf(bf_lo(b.z)), bf_hi(a.z) * __builtin_amdgcn_rcpf(bf_hi(b.z)), bf_lo(a.w) * __builtin_amdgcn_rcpf(bf_lo(b.w)), bf_hi(a.w) * __builtin_amdgcn_rcpf(bf_hi(b.w))};
                    acc[ai][bj][m][0] *= r0; acc[ai][bj][m][1] *= r1; }
            asm volatile("" ::: "memory"); }
        asm volatile("s_waitcnt vmcnt(0)" ::: "memory");
    }
    __device__ __forceinline__ void operator()(const f32x4 (&acc)[2][2][4][2], const Unit& u, int wr, int wc, int fr, int fq) const {
        const int row0 = u.pm * BM + wr * 64 + fr, col0 = u.pn * BM + wc * 32 + 8 * fq;
#pragma unroll
        for (int ai = 0; ai < 2; ++ai) {
            u32x4 gq[4][2];
#pragma unroll
            for (int m = 0; m < 4; ++m)
#pragma unroll
                for (int bj = 0; bj < 2; ++bj) gq[m][bj] = *(const u32x4*)(G + (size_t)(row0 + ai * HALF + m * 16) * 6144 + 4096 + col0 + bj * HALF);
#pragma unroll
            for (int m = 0; m < 4; ++m) { const size_t row = (size_t)(row0 + ai * HALF + m * 16);
#pragma unroll
                for (int bj = 0; bj < 2; ++bj) { const int col = col0 + bj * HALF; const u32x4 gv = gq[m][bj];
                    const f32x4 a0 = acc[ai][bj][m][0], a1 = acc[ai][bj][m][1];
                    u32x4 w; w.x = cvt_pk_bf16(bf_lo(gv.x) * a0[0], bf_hi(gv.x) * a0[1]); w.y = cvt_pk_bf16(bf_lo(gv.y) * a0[2], bf_hi(gv.y) * a0[3]);
                    w.z = cvt_pk_bf16(bf_lo(gv.z) * a1[0], bf_hi(gv.z) * a1[1]); w.w = cvt_pk_bf16(bf_lo(gv.w) * a1[2], bf_hi(gv.w) * a1[3]);
                    *(u32x4*)(MG + row * 2048 + col) = w; } } }
    }
};
template <class Epi, class Sched, bool ALIGN_EPI = false, bool SP2 = false>
__device__ __forceinline__ void gemm_phase(PG8_LAS unsigned char* lds, const Gemm g, const Sched& S, const Epi& E) {
    const int tid = threadIdx.x, wid = __builtin_amdgcn_readfirstlane(tid >> 6), lane = tid & 63, wr = wid >> 2, wc = wid & 3, fr = lane & 15, fq = lane >> 4;
    const int K = g.K, nt = K / BK;
    unsigned voffA[2], voffB[2];
#pragma unroll
    for (int i = 0; i < 2; ++i) { int R, C; stage_rc(tid * 16 + i * 8192, R, C); const int Rb = Epi::PERM ? ((R & ~31) + perm32(R & 31)) : R;
        voffA[i] = (unsigned)(R * K + C) * 2u; voffB[i] = (unsigned)(Rb * K + C) * 2u; }
    const size_t kstep = (size_t)(BK * 2);
    const size_t hstep = (size_t)HALF * K * 2;
    const size_t tstep = 2 * hstep;
    const unsigned ldsw = (unsigned)wid * 1024u;
    const int aoff = lds_byte(wr * 64 + fr, fq * 8), boff = lds_byte(wc * 32 + fr, fq * 8);
#define PG8_SA(b, h) (((b) * 2 + (h)) * HTB)
#define PG8_SB(b, h) ((4 + (b) * 2 + (h)) * HTB)
#define PG8_STAGE(bufoff, gbase, voff) do { _Pragma("unroll") for (int _i = 0; _i < 2; ++_i) \
        __builtin_amdgcn_global_load_lds((const unsigned*)((const char*)(gbase) + (voff)[_i]), (PG8_LAS unsigned*)(lds + (bufoff) + ldsw + _i * 8192), 16, 0, 0); } while (0)
#define PG8_LDA(dst, b, h) do { _Pragma("unroll") for (int m = 0; m < 4; ++m) _Pragma("unroll") for (int k = 0; k < 2; ++k) dst[m][k] = *(const PG8_LAS bf16x8*)(lds + PG8_SA(b, h) + aoff + m * 2048 + k * 1024); } while (0)
#define PG8_LDB(dst, b, h) do { _Pragma("unroll") for (int n = 0; n < 2; ++n) _Pragma("unroll") for (int k = 0; k < 2; ++k) dst[n][k] = *(const PG8_LAS bf16x8*)(lds + PG8_SB(b, h) + boff + n * 2048 + k * 1024); } while (0)
#define PG8_MMA(ai, bj, At, Bt) do { __builtin_amdgcn_s_setprio(1); _Pragma("unroll") for (int m = 0; m < 4; ++m) _Pragma("unroll") for (int n = 0; n < 2; ++n) _Pragma("unroll") for (int k = 0; k < 2; ++k) \
        acc[ai][bj][m][n] = __builtin_amdgcn_mfma_f32_16x16x32_bf16(Bt[n][k], At[m][k], acc[ai][bj][m][n], 0, 0, 0); __builtin_amdgcn_s_setprio(0); } while (0)
#define PG8_WAIT_V(n) asm volatile("s_waitcnt vmcnt(" #n ")" ::: "memory")
#define PG8_WAIT_L(n) asm volatile("s_waitcnt lgkmcnt(" #n ")" ::: "memory")
#define PG8_BAR __builtin_amdgcn_s_barrier()
#define PG8_SCHED __builtin_amdgcn_sched_barrier(0)
    Unit cur, nxt; int ui = 0;
    if (!S.next(0, cur)) return;
    f32x4 acc[2][2][4][2];
    float ectx[8] = {1.f, 1.f, 1.f, 1.f, 1.f, 1.f, 1.f, 1.f}; int ectx_pm = -1;
#pragma unroll
    for (int a = 0; a < 2; ++a)
#pragma unroll
        for (int b = 0; b < 2; ++b)
#pragma unroll
            for (int m = 0; m < 4; ++m)
#pragma unroll
                for (int n = 0; n < 2; ++n) acc[a][b][m][n] = (f32x4){0.f, 0.f, 0.f, 0.f};
    bf16x8 At[4][2], B0[2][2], B1[2][2];
    const char* cA = (const char*)g.A + (size_t)cur.pm * tstep; const char* cB = (const char*)g.Bt + (size_t)cur.pn * tstep;
    S.a_ready(cur);
    if constexpr (SP2) {
        PG8_STAGE(PG8_SB(0, 0), cB, voffB); PG8_STAGE(PG8_SB(0, 1), cB + hstep, voffB); PG8_STAGE(PG8_SA(0, 0), cA, voffA); PG8_STAGE(PG8_SA(0, 1), cA + hstep, voffA);
        if (wr == 1) PG8_BAR;
        PG8_WAIT_V(2); PG8_BAR;
        PG8_STAGE(PG8_SB(1, 0), cB + kstep, voffB); PG8_STAGE(PG8_SA(1, 0), cA + kstep, voffA); PG8_STAGE(PG8_SB(1, 1), cB + hstep + kstep, voffB);
        PG8_WAIT_V(6); PG8_BAR;
    } else {
        PG8_STAGE(PG8_SB(0, 0), cB, voffB); PG8_STAGE(PG8_SA(0, 0), cA, voffA); PG8_STAGE(PG8_SB(0, 1), cB + hstep, voffB); PG8_STAGE(PG8_SA(0, 1), cA + hstep, voffA);
        if (wr == 1) PG8_BAR;
        PG8_WAIT_V(4); PG8_BAR;
        PG8_STAGE(PG8_SB(1, 0), cB + kstep, voffB); PG8_STAGE(PG8_SA(1, 0), cA + kstep, voffA); PG8_STAGE(PG8_SB(1, 1), cB + hstep + kstep, voffB);
        PG8_WAIT_V(6); PG8_BAR;
    }
    for (;;) {
        const bool has_next = S.next(ui + 1, nxt);
        const char* nA = has_next ? (const char*)g.A + (size_t)nxt.pm * tstep : cA; const char* nB = has_next ? (const char*)g.Bt + (size_t)nxt.pn * tstep : cB;
        for (int t = 0; t < nt; t += 2) {
            if constexpr (Epi::HOOK) { if (t == Epi::H1 || t == Epi::H2) E.hook(acc, cur, t, wr, wc, fr, fq); }
            const bool last = (t == nt - 2);
            const char* a1 = cA + (size_t)(t + 1) * kstep;
            const char* a2 = last ? nA : cA + (size_t)(t + 2) * kstep; const char* b2 = last ? nB : cB + (size_t)(t + 2) * kstep;
            const char* a3 = a2 + kstep; const char* b3 = b2 + kstep;
            if (last && has_next) S.a_ready(nxt);
            if constexpr (SP2) {
            PG8_LDB(B0, 0, 0); PG8_LDB(B1, 0, 1); PG8_SCHED; PG8_LDA(At, 0, 0); PG8_STAGE(PG8_SA(1, 1), a1 + hstep, voffA);
            PG8_WAIT_V(8); PG8_WAIT_L(0); PG8_BAR; PG8_MMA(0, 0, At, B0); PG8_MMA(0, 1, At, B1); PG8_BAR; PG8_SCHED;
            PG8_LDA(At, 0, 1); PG8_STAGE(PG8_SB(0, 0), b2, voffB); PG8_STAGE(PG8_SB(0, 1), b2 + hstep, voffB); PG8_STAGE(PG8_SA(0, 0), a2, voffA);
            PG8_WAIT_V(8); PG8_WAIT_L(0); PG8_BAR; PG8_MMA(1, 0, At, B0); PG8_MMA(1, 1, At, B1); PG8_BAR; PG8_SCHED;
            PG8_LDB(B0, 1, 0); PG8_LDB(B1, 1, 1); PG8_SCHED; PG8_LDA(At, 1, 0); PG8_STAGE(PG8_SA(0, 1), a2 + hstep, voffA);
            PG8_WAIT_V(8); PG8_WAIT_L(0); PG8_BAR; PG8_MMA(0, 0, At, B0); PG8_MMA(0, 1, At, B1); PG8_BAR; PG8_SCHED;
            PG8_LDA(At, 1, 1); PG8_STAGE(PG8_SB(1, 0), b3, voffB); PG8_STAGE(PG8_SB(1, 1), b3 + hstep, voffB); PG8_STAGE(PG8_SA(1, 0), a3, voffA);
            PG8_WAIT_V(8); PG8_WAIT_L(0); PG8_BAR; PG8_MMA(1, 0, At, B0); PG8_MMA(1, 1, At, B1); PG8_BAR; PG8_SCHED;
            } else {
            PG8_LDB(B0, 0, 0); PG8_SCHED; PG8_LDA(At, 0, 0); PG8_STAGE(PG8_SA(1, 1), a1 + hstep, voffA);
            PG8_WAIT_L(8); PG8_BAR; PG8_WAIT_L(0); PG8_MMA(0, 0, At, B0); PG8_BAR; PG8_SCHED;
            PG8_LDB(B1, 0, 1); PG8_STAGE(PG8_SB(0, 0), b2, voffB);
            PG8_BAR; PG8_WAIT_L(0); PG8_MMA(0, 1, At, B1); PG8_BAR;
            PG8_LDA(At, 0, 1); PG8_STAGE(PG8_SA(0, 0), a2, voffA);
            PG8_BAR; PG8_WAIT_L(0); PG8_MMA(1, 0, At, B0); PG8_BAR; PG8_SCHED;
            PG8_STAGE(PG8_SB(0, 1), b2 + hstep, voffB);
            PG8_WAIT_V(6); PG8_BAR; PG8_MMA(1, 1, At, B1); PG8_BAR;
            PG8_LDB(B0, 1, 0); PG8_SCHED; PG8_LDA(At, 1, 0); PG8_STAGE(PG8_SA(0, 1), a2 + hstep, voffA);
            PG8_WAIT_L(8); PG8_BAR; PG8_WAIT_L(0); PG8_MMA(0, 0, At, B0); PG8_BAR; PG8_SCHED;
            PG8_LDB(B1, 1, 1); PG8_STAGE(PG8_SB(1, 0), b3, voffB);
            PG8_BAR; PG8_WAIT_L(0); PG8_MMA(0, 1, At, B1); PG8_BAR;
            PG8_LDA(At, 1, 1); PG8_STAGE(PG8_SA(1, 0), a3, voffA);
            PG8_BAR; PG8_WAIT_L(0); PG8_MMA(1, 0, At, B0); PG8_BAR; PG8_SCHED;
            PG8_STAGE(PG8_SB(1, 1), b3 + hstep, voffB);
            PG8_WAIT_V(6); PG8_BAR; PG8_MMA(1, 1, At, B1); PG8_BAR;
            }
        }
        if constexpr (ALIGN_EPI) { if (wr == 0) PG8_BAR; }
        if constexpr (!Epi::AFTER_DRAIN) { if constexpr (Epi::CTX) E.run(acc, cur, wr, wc, fr, fq, ectx, ectx_pm); else E(acc, cur, wr, wc, fr, fq); S.done(cur); }
        if (!has_next) break;
#pragma unroll
        for (int a = 0; a < 2; ++a)
#pragma unroll
            for (int b = 0; b < 2; ++b)
#pragma unroll
                for (int m = 0; m < 4; ++m)
#pragma unroll
                    for (int n = 0; n < 2; ++n) acc[a][b][m][n] = (f32x4){0.f, 0.f, 0.f, 0.f};
        cur = nxt; cA = nA; cB = nB; ++ui;
        if constexpr (ALIGN_EPI) { if (wr == 1) PG8_BAR; }
    }
    PG8_WAIT_V(0);
    if constexpr (!ALIGN_EPI) { if (wr == 0) PG8_BAR; }
    PG8_BAR;
    if constexpr (Epi::AFTER_DRAIN) { E.fused(acc, cur, wr, wc, fr, fq, lds, wid, lane); S.done(cur); }
#undef PG8_SA
#undef PG8_SB
#undef PG8_STAGE
#undef PG8_LDA
#undef PG8_LDB
#undef PG8_MMA
#undef PG8_WAIT_V
#undef PG8_WAIT_L
#undef PG8_BAR
#undef PG8_SCHED
}
}
#include <hip/hip_bf16.h>
#include <cmath>
namespace attn_body {
using bf16=__hip_bfloat16;
using bf16x8=__attribute__((ext_vector_type(8)))short;
using s16x4=__attribute__((ext_vector_type(4)))short;
using f32x16=__attribute__((ext_vector_type(16)))float;
using u32x4=__attribute__((ext_vector_type(4)))unsigned;
constexpr int BATCH=16,NHEAD=16,SEQ=2048,D=64,DM=NHEAD*D;
constexpr int NW=8,QBLK=32,QB=QBLK*NW,KVBLK=64,NQB=SEQ/QB;
constexpr int ATTN_PITCH=DM, ATTN_UNIT_ROWS=QB, OPITCH=2048;
__device__ __forceinline__ int crow(int r,int hi){return (r&3)+8*(r>>2)+4*hi;}
#define SBAR() __builtin_amdgcn_sched_barrier(0)
__device__ __forceinline__ void cmask(f32x16&p0,f32x16&p1,int jb,int qrel,int hi){
  const float NEG=-INFINITY; int kb=64*jb+4*hi;
  #pragma unroll
  for(int r=0;r<16;++r){int kv=kb+(r&3)+8*(r>>2); if(kv>qrel)p0[r]=NEG; if(kv+32>qrel)p1[r]=NEG;}
}

constexpr int NSLOT=3, SLOTB=8192;
constexpr int LDS_K=0, LDS_V=NSLOT*SLOTB, LDS_WS=2*NSLOT*SLOTB, LDS_OST=LDS_WS+NW*64*4, LDS_KB=LDS_OST+NW*4096, LDS_BYTES=LDS_KB+SEQ*4;
constexpr float C2=0.125f*1.4426950408889634f;
__device__ __forceinline__ void glds16(const void*gsrc,unsigned lds_dst){unsigned keep;
  asm volatile("s_mov_b32 %0, m0\n\ts_mov_b32 m0, %2\n\ts_nop 0\n\tglobal_load_lds_dwordx4 %1, off\n\ts_mov_b32 m0, %0":"=&s"(keep):"v"(gsrc),"s"(lds_dst):"memory");}
__device__ __forceinline__ float max3f(float a,float b,float c){float r;asm("v_max3_f32 %0, %1, %2, %3":"=v"(r):"v"(a),"v"(b),"v"(c));return r;}
__device__ __forceinline__ float max2f(float a,float b){float r;asm("v_max_f32_e32 %0, %1, %2":"=v"(r):"v"(a),"v"(b));return r;}
__device__ __forceinline__ float fadd_s(float a,float b){float r;asm("v_add_f32_e32 %0, %1, %2":"=v"(r):"v"(a),"v"(b));return r;}
__device__ __forceinline__ float fsub_s(float a,float b){float r;asm("v_sub_f32_e32 %0, %1, %2":"=v"(r):"v"(a),"v"(b));return r;}
typedef float f32x2_t __attribute__((ext_vector_type(2))); typedef __bf16 bf16x2_t __attribute__((ext_vector_type(2)));
__device__ __forceinline__ unsigned cvtpk_s(float lo,float hi){f32x2_t v={lo,hi};bf16x2_t b=__builtin_convertvector(v,bf16x2_t);return __builtin_bit_cast(unsigned,b);}
#define WAIT_BAR(N) asm volatile("s_waitcnt vmcnt(" #N ") lgkmcnt(0)\n\ts_barrier":::"memory")

__device__ __forceinline__ void qkt(f32x16&p0,f32x16&p1,const char*Kslot,const bf16x8*qr,int r32,int hi){
  const char*kb=Kslot+hi*1024+r32*16;
  #pragma unroll
  for(int d0=0;d0<4;++d0){
    const bf16x8 b0=*reinterpret_cast<const bf16x8*>(kb+d0*2048);
    const bf16x8 b1=*reinterpret_cast<const bf16x8*>(kb+d0*2048+512);
    {p0=__builtin_amdgcn_mfma_f32_32x32x16_bf16(b0,qr[d0],p0,0,0,0);p1=__builtin_amdgcn_mfma_f32_32x32x16_bf16(b1,qr[d0],p1,0,0,0);}}
}
typedef __attribute__((address_space(3))) const char* lds_cptr;
typedef short v4i16_t __attribute__((ext_vector_type(4)));
__device__ __forceinline__ void kload8(bf16x8*kf,lds_cptr kp){
  kf[0]=*(const __attribute__((address_space(3))) bf16x8*)(kp);      kf[1]=*(const __attribute__((address_space(3))) bf16x8*)(kp+512);
  kf[2]=*(const __attribute__((address_space(3))) bf16x8*)(kp+2048); kf[3]=*(const __attribute__((address_space(3))) bf16x8*)(kp+2560);
  kf[4]=*(const __attribute__((address_space(3))) bf16x8*)(kp+4096); kf[5]=*(const __attribute__((address_space(3))) bf16x8*)(kp+4608);
  kf[6]=*(const __attribute__((address_space(3))) bf16x8*)(kp+6144); kf[7]=*(const __attribute__((address_space(3))) bf16x8*)(kp+6656);
}
__device__ __forceinline__ void kload2(bf16x8*kf,lds_cptr kp,int j){ kf[2*j]=*(const __attribute__((address_space(3))) bf16x8*)(kp+j*2048); kf[2*j+1]=*(const __attribute__((address_space(3))) bf16x8*)(kp+j*2048+512); }
__device__ __forceinline__ s16x4 vtr(lds_cptr p){ return __builtin_bit_cast(s16x4,__builtin_amdgcn_ds_read_tr16_b64_v4i16((__attribute__((address_space(3))) v4i16_t*)p)); }
__device__ __forceinline__ float rowmax(const f32x16&p0,const f32x16&p1){
  float a=max3f(p0[0],p0[1],p1[0]),b=max3f(p0[2],p0[3],p1[1]);a=max3f(a,p1[2],p1[3]);
  #pragma unroll
  for(int r=4;r<16;r+=4){a=max3f(a,p0[r],p0[r+1]);b=max3f(b,p0[r+2],p0[r+3]);a=max3f(a,p1[r],p1[r+1]);b=max3f(b,p1[r+2],p1[r+3]);}
  const float m=max2f(a,b);
  auto rr=__builtin_amdgcn_permlane32_swap(__float_as_uint(m),__float_as_uint(m),false,false);
  return max2f(__uint_as_float(rr[0]),__uint_as_float(rr[1]));
}
__device__ __forceinline__ void pv(f32x16*o,int vb,bf16x8 pa0,bf16x8 pa1,bf16x8 pa2,bf16x8 pa3){
  #pragma unroll
  for(int d0=0;d0<2;++d0){s16x4 lo[4],hi[4];
    #pragma unroll
    for(int ks=0;ks<4;++ks){
      asm volatile("ds_read_b64_tr_b16 %0,%1 offset:%c2":"=&v"(lo[ks]):"v"(vb),"i"(d0*4096+ks*1024):"memory");
      asm volatile("ds_read_b64_tr_b16 %0,%1 offset:%c2":"=&v"(hi[ks]):"v"(vb),"i"(d0*4096+ks*1024+512):"memory");}
    asm volatile("s_waitcnt lgkmcnt(0)":::"memory");SBAR();
    #define PK(k) (bf16x8){lo[k][0],lo[k][1],lo[k][2],lo[k][3],hi[k][0],hi[k][1],hi[k][2],hi[k][3]}
    o[d0]=__builtin_amdgcn_mfma_f32_32x32x16_bf16(pa0,PK(0),o[d0],0,0,0);
    o[d0]=__builtin_amdgcn_mfma_f32_32x32x16_bf16(pa1,PK(1),o[d0],0,0,0);
    o[d0]=__builtin_amdgcn_mfma_f32_32x32x16_bf16(pa2,PK(2),o[d0],0,0,0);
    o[d0]=__builtin_amdgcn_mfma_f32_32x32x16_bf16(pa3,PK(3),o[d0],0,0,0);
    #undef PK
  }
}

#ifndef ATTN_STORE16
#define ATTN_STORE16(p,v) (*(u32x4*)(p)=(v))
#endif
template<int THRL> __device__ __forceinline__ void attn_unit(int b,int h,int qb,const bf16*Q,const bf16*__restrict__ K,const bf16*__restrict__ V,bf16*O,const float*__restrict__ CL,char*shm,bool pre,bool nxt){
  const int tid=threadIdx.x,lane=tid&63,r32=lane&31,hi=lane>>5; const int wid=__builtin_amdgcn_readfirstlane(tid>>6);
  const long rowbase=(long)b*SEQ; const int q0=qb*QB;
  const bf16*Qw=Q+(rowbase+q0+wid*QBLK)*DM+h*D;
  const bf16*Kh=K+rowbase*DM+h*D,*Vh=V+rowbase*DM+h*D;
  const unsigned lds0=(unsigned)(uintptr_t)shm;
  float*wsf=(float*)(shm+LDS_WS)+wid*64;
  typedef __attribute__((address_space(3))) float lds_f32; typedef float f32x4_t __attribute__((ext_vector_type(4)));
  lds_f32*kbl3=(lds_f32*)((__attribute__((address_space(3))) char*)shm+LDS_KB);
  const float clq=-kbl3[qb*QB+wid*QBLK+(lane&31)];
  const bf16*ksrc=Kh+(long)lane*DM+wid*8;
  const bf16*vsrc=Vh+(long)(16*(wid&3)+(lane>>2))*DM+(wid>>2)*32+(lane&3)*8;
  const unsigned kdst=lds0+LDS_K+wid*1024, vdst=lds0+LDS_V+wid*1024;
  #define DMA_K(t,slot) glds16(ksrc+(long)(t)*KVBLK*DM,(unsigned)__builtin_amdgcn_readfirstlane(kdst+(slot)))
  #define DMA_V(t,slot) glds16(vsrc+(long)(t)*KVBLK*DM,(unsigned)__builtin_amdgcn_readfirstlane(vdst+(slot)))
  const int vb0=(int)(lds0+LDS_V)+((lane>>4)&1)*32+(lane&3)*8+(4*hi+((lane&15)>>2))*64;
  const char*Kbase=shm+LDS_K; bf16x8 kf[8];
  const lds_cptr shm3=(lds_cptr)shm; const lds_cptr kp0=shm3+LDS_K+hi*1024+r32*16; const lds_cptr vp0=shm3+LDS_V+((lane>>4)&1)*32+(lane&3)*8+(4*hi+((lane&15)>>2))*64;
  const int NT=(q0+QB)/KVBLK;
  if(!pre){DMA_K(0,0);DMA_V(0,0);DMA_K(1,SLOTB);}
  bf16x8 qr[4];
  #pragma unroll
  for(int d0=0;d0<4;++d0)qr[d0]=*reinterpret_cast<const bf16x8*>(&Qw[(long)r32*DM+d0*16+hi*8]);
  float mhat=-clq,l_reg=0.f;f32x16 o[2];o[0]=f32x16{};o[1]=f32x16{};
  #define KINIT(X0,X1,t) do{ const __attribute__((address_space(3))) f32x4_t* kb_=(const __attribute__((address_space(3))) f32x4_t*)(kbl3+(t)*KVBLK+4*hi); \
    _Pragma("unroll") for(int g_=0;g_<4;++g_){ const f32x4_t ka_=kb_[2*g_], kc_=kb_[2*g_+8]; \
      X0[4*g_]=ka_[0]-mhat;X0[4*g_+1]=ka_[1]-mhat;X0[4*g_+2]=ka_[2]-mhat;X0[4*g_+3]=ka_[3]-mhat; X1[4*g_]=kc_[0]-mhat;X1[4*g_+1]=kc_[1]-mhat;X1[4*g_+2]=kc_[2]-mhat;X1[4*g_+3]=kc_[3]-mhat; } }while(0)
  #define KLOAD(X0,X1,t) do{ const __attribute__((address_space(3))) f32x4_t* kb_=(const __attribute__((address_space(3))) f32x4_t*)(kbl3+(t)*KVBLK+4*hi); \
    _Pragma("unroll") for(int g_=0;g_<4;++g_){ const f32x4_t ka_=kb_[2*g_], kc_=kb_[2*g_+8]; \
      X0[4*g_]=ka_[0];X0[4*g_+1]=ka_[1];X0[4*g_+2]=ka_[2];X0[4*g_+3]=ka_[3]; X1[4*g_]=kc_[0];X1[4*g_+1]=kc_[1];X1[4*g_+2]=kc_[2];X1[4*g_+3]=kc_[3]; } }while(0)
  #define KSUB(X0,X1) do{ _Pragma("unroll") for(int r_=0;r_<16;++r_){ X0[r_]-=mhat; X1[r_]-=mhat; } }while(0)
  const int qrel=wid*QBLK+r32;
  #define CMASK(P0,P1,t) do{int jb_=(t)-(NT-4); if(jb_>=0)cmask(P0,P1,jb_,qrel,hi);}while(0)
  bool resc=false;
  #define START(P0,P1) do{ const float rm=rowmax(P0,P1); resc=false; \
    { const float dl=rm; mhat=fadd_s(mhat,dl); \
      _Pragma("unroll") for(int r=0;r<16;++r){P0[r]=fsub_s(P0[r],dl);P1[r]=fsub_s(P1[r],dl);} \
      } \
    _Pragma("unroll") for(int r=0;r<16;++r)P0[r]=__builtin_amdgcn_exp2f(P0[r]); }while(0)
  #define RESC() do{ if(resc){ asm volatile("s_waitcnt lgkmcnt(0)":::"memory"); \
      _Pragma("unroll") for(int d_=0;d_<2;++d_) _Pragma("unroll") for(int r=0;r<16;++r)o[d_][r]*=wsf[crow(r,hi)]; } }while(0)
  f32x16 pA0,pA1,pB0,pB1;
  int sl_prev=0,sl_cur=0,sl_next=SLOTB;
  #define ROT() do{sl_prev=sl_cur;sl_cur=sl_next;sl_next=(sl_next==(NSLOT-1)*SLOTB)?0:sl_next+SLOTB;}while(0)
  if(!pre){DMA_K(2,2*SLOTB);}
  WAIT_BAR(3);
  KINIT(pA0,pA1,0);qkt(pA0,pA1,Kbase,qr,r32,hi);asm volatile("s_nop 15\n\ts_nop 7":"+v"(pA0),"+v"(pA1));CMASK(pA0,pA1,0);
  START(pA0,pA1);
  _Pragma("unroll") for(int r=0;r<16;++r)pA1[r]=__builtin_amdgcn_exp2f(pA1[r]);
  KINIT(pB0,pB1,1);
  WAIT_BAR(0);
  DMA_K(3,0);DMA_V(1,SLOTB);
  ROT();
  kload8(kf,kp0+sl_cur);
  WAIT_BAR(2);
  s16x4 vlo[8],vhi[8]; u32x4 pw0,pw1,pw2,pw3;
  #define PKW(P,B) cvtpk_s(P[B],P[B+1])
  #define PAF(k) __builtin_bit_cast(bf16x8,pw##k)
  #define VFR(i) (bf16x8){vlo[i][0],vlo[i][1],vlo[i][2],vlo[i][3],vhi[i][0],vhi[i][1],vhi[i][2],vhi[i][3]}
  #define PIN(x) asm volatile("":"+v"(x))
  #define MX3(a,b,c) __builtin_fmaxf(__builtin_fmaxf((a),(b)),(c))
  #define GAPA(MF,A0,A1,A2,A3,W0,W1,PW) do{ MF; sacc+=A0; sacc+=A1; sacc+=A2; sacc+=A3; PIN(sacc); W0; W1; PIN(PW); SBAR(); }while(0)
  #define EX(v) __builtin_amdgcn_exp2f(v)
  #define GAPB(MF,X,B) do{ MF; X[B]=EX(X[B]); X[B+1]=EX(X[B+1]); X[B+2]=EX(X[B+2]); X[B+3]=EX(X[B+3]); PIN(X); SBAR(); }while(0)
  #define VRD(i) do{ vlo[i]=vtr(vp_+(((i)>>2)*4096+((i)&3)*1024)); vhi[i]=vtr(vp_+(((i)>>2)*4096+((i)&3)*1024+512)); }while(0)
  #define KRD(G,j) do{ if(G){ kload2(kf,kp0+sl_next,j); SBAR(); } }while(0)
  #define STEP(C0,C1,P0,P1,t,GK,GV,GL) do{ SBAR(); \
    const lds_cptr vp_=vp0+sl_prev; \
    VRD(0); SBAR(); float sacc=(P0[0]+P0[1]); \
    GAPA(C0=__builtin_amdgcn_mfma_f32_32x32x16_bf16(kf[0],qr[0],C0,0,0,0), P0[2],P0[3],P0[4],P0[5],     pw0[0]=PKW(P0,0), pw0[1]=PKW(P0,2), pw0); \
    VRD(4); SBAR(); GAPA(C1=__builtin_amdgcn_mfma_f32_32x32x16_bf16(kf[1],qr[0],C1,0,0,0), P0[6],P0[7],P0[8],P0[9],     pw0[2]=PKW(P0,4), pw0[3]=PKW(P0,6), pw0); \
    VRD(1); SBAR(); GAPA(C0=__builtin_amdgcn_mfma_f32_32x32x16_bf16(kf[2],qr[1],C0,0,0,0),   P0[10],P0[11],P0[12],P0[13], pw1[0]=PKW(P0,8), pw1[1]=PKW(P0,10), pw1); \
    VRD(5); SBAR(); GAPA(C1=__builtin_amdgcn_mfma_f32_32x32x16_bf16(kf[3],qr[1],C1,0,0,0),   P0[14],P0[15],P1[0],P1[1],   pw1[2]=PKW(P0,12),pw1[3]=PKW(P0,14), pw1); \
    VRD(2); SBAR(); GAPA(C0=__builtin_amdgcn_mfma_f32_32x32x16_bf16(kf[4],qr[2],C0,0,0,0),   P1[2],P1[3],P1[4],P1[5],     pw2[0]=PKW(P1,0), pw2[1]=PKW(P1,2), pw2); \
    VRD(6); SBAR(); GAPA(C1=__builtin_amdgcn_mfma_f32_32x32x16_bf16(kf[5],qr[2],C1,0,0,0),   P1[6],P1[7],P1[8],P1[9],     pw2[2]=PKW(P1,4), pw2[3]=PKW(P1,6), pw2); \
    VRD(3); SBAR(); GAPA(C0=__builtin_amdgcn_mfma_f32_32x32x16_bf16(kf[6],qr[3],C0,0,0,0),   P1[10],P1[11],P1[12],P1[13], pw3[0]=PKW(P1,8), pw3[1]=PKW(P1,10), pw3); \
    VRD(7); SBAR(); GAPA(C1=__builtin_amdgcn_mfma_f32_32x32x16_bf16(kf[7],qr[3],C1,0,0,0),   P1[14],P1[15],0.f,0.f,       pw3[2]=PKW(P1,12),pw3[3]=PKW(P1,14), pw3); \
    l_reg+=sacc; \
    if(GK){DMA_K((t)+3,sl_cur);} if(GV){DMA_V((t)+1,sl_next);} \
    CMASK(C0,C1,t); \
    { float a=MX3(C0[0],C0[1],C1[0]),b=MX3(C0[2],C0[3],C1[1]); a=MX3(a,C1[2],C1[3]); \
      _Pragma("unroll") for(int r=4;r<16;r+=4){a=MX3(a,C0[r],C0[r+1]);b=MX3(b,C0[r+2],C0[r+3]);a=MX3(a,C1[r],C1[r+1]);b=MX3(b,C1[r+2],C1[r+3]);} \
      float rm=__builtin_fmaxf(a,b); { auto rr=__builtin_amdgcn_permlane32_swap(__float_as_uint(rm),__float_as_uint(rm),false,false); rm=__builtin_fmaxf(__uint_as_float(rr[0]),__uint_as_float(rr[1])); } \
      resc=false; \
      if(__builtin_expect(__any(rm>(float)THRL),0)){ const float dl=__builtin_fmaxf(rm,0.f); mhat+=dl; \
        _Pragma("unroll") for(int r=0;r<16;++r){C0[r]-=dl;C1[r]-=dl;} \
        const float f=__builtin_amdgcn_exp2f(-dl); l_reg*=f; if(hi==0)wsf[r32]=f; resc=true; } } \
    SBAR(); \
    if(GV){ KLOAD(P0,P1,(t)+1); } SBAR(); \
    GAPB(o[0]=__builtin_amdgcn_mfma_f32_32x32x16_bf16(PAF(0),VFR(0),o[0],0,0,0), C0,0); \
    GAPB(o[1]=__builtin_amdgcn_mfma_f32_32x32x16_bf16(PAF(0),VFR(4),o[1],0,0,0), C0,4); \
    KRD(GL,0); GAPB(o[0]=__builtin_amdgcn_mfma_f32_32x32x16_bf16(PAF(1),VFR(1),o[0],0,0,0), C0,8); \
    KRD(GL,1); GAPB(o[1]=__builtin_amdgcn_mfma_f32_32x32x16_bf16(PAF(1),VFR(5),o[1],0,0,0), C0,12); \
    KRD(GL,2); GAPB(o[0]=__builtin_amdgcn_mfma_f32_32x32x16_bf16(PAF(2),VFR(2),o[0],0,0,0), C1,0); \
    KRD(GL,3); GAPB(o[1]=__builtin_amdgcn_mfma_f32_32x32x16_bf16(PAF(2),VFR(6),o[1],0,0,0), C1,4); \
    GAPB(o[0]=__builtin_amdgcn_mfma_f32_32x32x16_bf16(PAF(3),VFR(3),o[0],0,0,0), C1,8); \
    GAPB(o[1]=__builtin_amdgcn_mfma_f32_32x32x16_bf16(PAF(3),VFR(7),o[1],0,0,0), C1,12); \
    if(GV){ KSUB(P0,P1); } \
    }while(0)
  int t=1;
  #undef CMASK
  #define CMASK(P0,P1,t) do{}while(0)
  for(;t+5<NT;t+=2){
    STEP(pB0,pB1,pA0,pA1,t,true,true,true);     WAIT_BAR(2); RESC(); ROT();
    STEP(pA0,pA1,pB0,pB1,t+1,true,true,true);   WAIT_BAR(2); RESC(); ROT();
  }
  #undef CMASK
  #define CMASK(P0,P1,t) do{int jb_=(t)-(NT-4); if(jb_>=0)cmask(P0,P1,jb_,qrel,hi);}while(0)
  #define ENDW(tt) do{ if((tt)+3<NT){WAIT_BAR(2);} else if((tt)+2<NT){WAIT_BAR(1);} else {WAIT_BAR(0);} }while(0)
  for(;t+1<NT;t+=2){
    STEP(pB0,pB1,pA0,pA1,t,(t+3<NT),(t+1<NT),(t+1<NT));       ENDW(t);   RESC(); ROT();
    STEP(pA0,pA1,pB0,pB1,t+1,(t+4<NT),(t+2<NT),(t+2<NT));     ENDW(t+1); RESC(); ROT();
  }
  STEP(pB0,pB1,pA0,pA1,NT-1,false,false,false); RESC();
  { float sacc=pB0[0]+pB0[1]; _Pragma("unroll") for(int r=2;r<16;++r)sacc+=pB0[r]; _Pragma("unroll") for(int r=0;r<16;++r)sacc+=pB1[r]; l_reg+=sacc;
    pw0=(u32x4){PKW(pB0,0),PKW(pB0,2),PKW(pB0,4),PKW(pB0,6)};pw1=(u32x4){PKW(pB0,8),PKW(pB0,10),PKW(pB0,12),PKW(pB0,14)};pw2=(u32x4){PKW(pB1,0),PKW(pB1,2),PKW(pB1,4),PKW(pB1,6)};pw3=(u32x4){PKW(pB1,8),PKW(pB1,10),PKW(pB1,12),PKW(pB1,14)};
    SBAR(); pv(o,vb0+sl_cur,PAF(0),PAF(1),PAF(2),PAF(3)); }
  if(nxt){ asm volatile("s_waitcnt lgkmcnt(0)\n\ts_barrier":::"memory"); DMA_K(0,0);DMA_V(0,0);DMA_K(1,SLOTB);DMA_K(2,2*SLOTB); }
  #undef PKW
  #undef PAF
  #undef VFR
  #undef PIN
  #undef MX3
  #undef GAPA
  #undef GAPB
  #undef EX
  #undef VRD
  #undef KRD
  #undef STEP
  #undef ENDW
  {auto rr=__builtin_amdgcn_permlane32_swap(__float_as_uint(l_reg),__float_as_uint(l_reg),false,false);l_reg=__uint_as_float(rr[0])+__uint_as_float(rr[1]);}
  if(hi==0)wsf[32+r32]=l_reg;asm volatile("s_waitcnt lgkmcnt(0)":::"memory");
  float rli[16];
  #pragma unroll
  for(int r=0;r<16;++r)rli[r]=__builtin_amdgcn_rcpf(wsf[32+crow(r,hi)]);
  bf16*Ow=O+(rowbase+q0+wid*QBLK)*OPITCH+h*D;
  { bf16*stg=(bf16*)(shm+LDS_OST)+wid*2048;
    #pragma unroll
    for(int r=0;r<16;++r){const int orow=crow(r,hi);
      #pragma unroll
      for(int d0=0;d0<2;++d0)stg[orow*64+d0*32+r32]=__float2bfloat16(o[d0][r]*rli[r]);}
    asm volatile("s_waitcnt lgkmcnt(0)":::"memory");
    #pragma unroll
    for(int i=0;i<4;++i){const int row=i*8+(lane>>3),ch=lane&7; const u32x4 v=*(const u32x4*)(stg+row*64+ch*8); ATTN_STORE16(Ow+(long)row*OPITCH+ch*8,v);} }
  asm volatile("s_waitcnt lgkmcnt(0)\n\ts_barrier":::"memory");
  #undef KINIT
  #undef KLOAD
  #undef KSUB
  #undef DMA_K
  #undef DMA_V
  #undef CMASK
  #undef START
  #undef RESC
  #undef ROT
}
constexpr int ATTN_LDS_BYTES=LDS_BYTES;
struct AttnTensors { const bf16* Q; const bf16* K; const bf16* V; bf16* O; const float* CL; };
struct AttnUnit { int bh; int qb; };
struct StaticOrder {
  int vcu, G;
  __device__ __forceinline__ explicit StaticOrder(int grid,int v):vcu(v),G(grid){}
  __device__ __forceinline__ bool next(int i,AttnUnit&u)const{ const int bh=vcu+(i/NQB)*G; if(bh>=BATCH*NHEAD)return false; u.bh=bh; u.qb=NQB-1-(i%NQB); return true; }
  __device__ __forceinline__ void a_ready(const AttnUnit&)const{}
  __device__ __forceinline__ void done(const AttnUnit&)const{}
};
__device__ __forceinline__ void build_bias(int b,int h,const float*__restrict__ LOGF,char*shm){
  typedef __attribute__((address_space(3))) float lds_f32; typedef float f32x4_t __attribute__((ext_vector_type(4)));
  const int tid=threadIdx.x,lane=tid&63; const int wid=__builtin_amdgcn_readfirstlane(tid>>6);
  lds_f32*kbl3=(lds_f32*)((__attribute__((address_space(3))) char*)shm+LDS_KB); lds_f32*wtot=(lds_f32*)((__attribute__((address_space(3))) char*)shm+LDS_WS);
  const float*src=LOGF+((long)b*SEQ+4*tid)*NHEAD+h;
  float a0=src[0],a1=src[NHEAD],a2=src[2*NHEAD],a3=src[3*NHEAD]; a1+=a0;a2+=a1;a3+=a2;
  float inc=a3;
  #pragma unroll
  for(int o=1;o<64;o<<=1){ const float t=__shfl_up(inc,o); if(lane>=o)inc+=t; }
  if(lane==63)wtot[wid]=inc;
  asm volatile("s_waitcnt lgkmcnt(0)\n\ts_barrier":::"memory");
  float base=0.f;
  #pragma unroll
  for(int w=0;w<NW;++w){ const float t=wtot[w]; if(w<wid)base+=t; }
  const float ex=base+inc-a3; const float c=-1.4426950408889634f;
  *(__attribute__((address_space(3))) f32x4_t*)(kbl3+4*tid)=(f32x4_t){(ex+a0)*c,(ex+a1)*c,(ex+a2)*c,(ex+a3)*c};
  asm volatile("s_waitcnt lgkmcnt(0)\n\ts_barrier":::"memory");
}
template<class Sched,int THRL=8> __device__ __forceinline__ void attn_phase(char*lds,const AttnTensors&T,const Sched&S){
  AttnUnit u,un; int cur_bh=-1; bool have=S.next(0,u);
  for(int i=0;have;++i){ const bool fresh=(u.bh!=cur_bh); if(fresh){ build_bias(u.bh/NHEAD,u.bh%NHEAD,T.CL,lds); cur_bh=u.bh; }
    const bool hn=S.next(i+1,un); const bool nxt=hn&&(un.bh==u.bh);
    S.a_ready(u); attn_unit<THRL>(u.bh/NHEAD,u.bh%NHEAD,u.qb,T.Q,T.K,T.V,T.O,T.CL,lds,!fresh,nxt); S.done(u);
    u=un; have=hn; }
}
#undef SBAR
#undef WAIT_BAR
}
namespace memattn {
using attn_body::bf16x8; using attn_body::f32x16; using attn_body::s16x4; using attn_body::u32x4;
#define MLAS __attribute__((address_space(3)))
constexpr int KSTR = 272, VSTR = 520, K_OFF = 0, V_OFF = 256 * KSTR, WSF_OFF = V_OFF + 128 * VSTR, MEM_LDS_BYTES = WSF_OFF + 8 * 256;
__device__ __forceinline__ void stage_kv(int b, int hm, const unsigned short* KM, const unsigned short* VT, const float* kgain, MLAS unsigned char* L) {
    int tid = threadIdx.x; asm volatile("" : "+v"(tid));
    { const int c = tid & 15, r0 = tid >> 4;
      const unsigned short* src = KM + ((long)b * 256 + r0) * 512 + hm * 128 + c * 8;
      float g[8];
#pragma unroll
      for (int j = 0; j < 8; ++j) g[j] = kgain[c * 8 + j];
      u32x4 vv[8];
#pragma unroll
      for (int p = 0; p < 8; ++p) vv[p] = *reinterpret_cast<const u32x4*>(src + (long)p * 32 * 512);
#pragma unroll
      for (int p = 0; p < 8; ++p) { const u32x4 v = vv[p];
          float f[8] = {__uint_as_float(v.x << 16), __uint_as_float(v.x & 0xffff0000u), __uint_as_float(v.y << 16), __uint_as_float(v.y & 0xffff0000u), __uint_as_float(v.z << 16), __uint_as_float(v.z & 0xffff0000u), __uint_as_float(v.w << 16), __uint_as_float(v.w & 0xffff0000u)};
          float ss = 0.f;
#pragma unroll
          for (int j = 0; j < 8; ++j) ss += f[j] * f[j];
          ss += __shfl_xor(ss, 1); ss += __shfl_xor(ss, 2); ss += __shfl_xor(ss, 4); ss += __shfl_xor(ss, 8);
          const float r = 1.0f / sqrtf(ss * (1.0f / 128.0f) + 1e-6f);
          u32x4 o; o.x = attn_body::cvtpk_s(f[0] * r * g[0], f[1] * r * g[1]); o.y = attn_body::cvtpk_s(f[2] * r * g[2], f[3] * r * g[3]); o.z = attn_body::cvtpk_s(f[4] * r * g[4], f[5] * r * g[5]); o.w = attn_body::cvtpk_s(f[6] * r * g[6], f[7] * r * g[7]);
          *(MLAS u32x4*)(L + K_OFF + (p * 32 + r0) * KSTR + c * 16) = o; } }
    { const int c = tid & 31, r0 = tid >> 5;
      typedef unsigned u32x2_t __attribute__((ext_vector_type(2)));
      const unsigned short* src = VT + ((long)hm * 128 + r0) * 4096 + b * 256 + c * 8;
#pragma unroll
      for (int p = 0; p < 8; ++p) { const u32x4 v = *reinterpret_cast<const u32x4*>(src + (long)p * 16 * 4096); MLAS unsigned char* d = L + V_OFF + (p * 16 + r0) * VSTR + c * 16;
          *(MLAS u32x2_t*)d = (u32x2_t){v.x, v.y}; *(MLAS u32x2_t*)(d + 8) = (u32x2_t){v.z, v.w}; } }
}
__device__ __forceinline__ void unit(int b, int hm, int qb, const unsigned short* QM, unsigned short* OM, MLAS unsigned char* L) {
    int tid = threadIdx.x; asm volatile("" : "+v"(tid)); const int lane = tid & 63, r32 = lane & 31, hi = lane >> 5; const int wid = __builtin_amdgcn_readfirstlane(tid >> 6);
    MLAS float* wsf = (MLAS float*)(L + WSF_OFF + wid * 256);
    const long row0 = (long)b * 2048 + qb * 256 + wid * 32;
    const unsigned short* Qw = QM + (row0 + r32) * 512 + hm * 128 + hi * 8;
    bf16x8 qr[8];
#pragma unroll
    for (int d0 = 0; d0 < 8; ++d0) qr[d0] = *reinterpret_cast<const bf16x8*>(Qw + d0 * 16);
    const MLAS unsigned char* Kb = L + K_OFF + r32 * KSTR + hi * 16;
    f32x16 s[8];
#pragma unroll
    for (int kb = 0; kb < 8; ++kb) { f32x16 a = f32x16{};
#pragma unroll
        for (int d0 = 0; d0 < 8; ++d0) { const bf16x8 kf = *(const MLAS bf16x8*)(Kb + kb * 32 * KSTR + d0 * 32); a = __builtin_amdgcn_mfma_f32_32x32x16_bf16(kf, qr[d0], a, 0, 0, 0); }
        s[kb] = a; }
    float mx = s[0][0];
#pragma unroll
    for (int kb = 0; kb < 8; ++kb)
#pragma unroll
        for (int r = 0; r < 16; ++r) mx = fmaxf(mx, s[kb][r]);
    mx = fmaxf(mx, __shfl_xor(mx, 32));
    float l = 0.f;
#pragma unroll
    for (int kb = 0; kb < 8; ++kb)
#pragma unroll
        for (int r = 0; r < 16; ++r) { const float e = __builtin_amdgcn_exp2f(s[kb][r] - mx); s[kb][r] = e; l += e; }
    l += __shfl_xor(l, 32);
    if (hi == 0) wsf[r32] = l;
    const MLAS unsigned char* Vb = L + V_OFF + r32 * VSTR + hi * 8;
    f32x16 o[4]; o[0] = f32x16{}; o[1] = f32x16{}; o[2] = f32x16{}; o[3] = f32x16{};
#pragma unroll
    for (int ks = 0; ks < 16; ++ks) { const int kb = ks >> 1, h8 = (ks & 1) * 8;
        u32x4 pw; pw.x = attn_body::cvtpk_s(s[kb][h8 + 0], s[kb][h8 + 1]); pw.y = attn_body::cvtpk_s(s[kb][h8 + 2], s[kb][h8 + 3]); pw.z = attn_body::cvtpk_s(s[kb][h8 + 4], s[kb][h8 + 5]); pw.w = attn_body::cvtpk_s(s[kb][h8 + 6], s[kb][h8 + 7]);
        const bf16x8 pa = __builtin_bit_cast(bf16x8, pw);
#pragma unroll
        for (int db = 0; db < 4; ++db) { const MLAS unsigned char* vp = Vb + db * 32 * VSTR + ks * 32;
            const s16x4 lo = *(const MLAS s16x4*)vp, h4 = *(const MLAS s16x4*)(vp + 16);
            const bf16x8 vf = (bf16x8){lo[0], lo[1], lo[2], lo[3], h4[0], h4[1], h4[2], h4[3]};
            o[db] = __builtin_amdgcn_mfma_f32_32x32x16_bf16(pa, vf, o[db], 0, 0, 0); } }
    asm volatile("s_waitcnt lgkmcnt(0)" ::: "memory");
    unsigned short* Ow = OM + row0 * 2048 + hm * 128 + r32;
#pragma unroll
    for (int r = 0; r < 16; ++r) { const int q = attn_body::crow(r, hi); const float rl = __builtin_amdgcn_rcpf(wsf[q]);
#pragma unroll
        for (int db = 0; db < 4; ++db) { const unsigned w = attn_body::cvtpk_s(o[db][r] * rl, 0.f); Ow[(long)q * 2048 + db * 32] = (unsigned short)(w & 0xffffu); } }
    asm volatile("s_waitcnt lgkmcnt(0)" ::: "memory");
}
#undef MLAS
}

constexpr int NWAVES = 8;
#ifndef MK_N_LAUNCHES
#define MK_N_LAUNCHES 1
#endif
constexpr int NPH = 12;
#ifndef PROBE_DOUBLE_MASK
#define PROBE_DOUBLE_MASK 0
#endif
constexpr int B_ = 16, S_ = 2048, DM_ = 2048, M_ = B_ * S_, FF_ = 5632, MEML = 256, MM_ = B_ * MEML;
constexpr int NWIN = 10496, NWIN_SRC = 10256;
constexpr float EPS_ = 1e-6f, LOG2E = 1.4426950408889634f;
constexpr size_t MiB = 1u << 20;
constexpr size_t WS_GU = 1 * MiB, WS_DN = 45 * MiB, WS_WIN = 67 * MiB, WS_WMKV = 108 * MiB, WS_WCAT = 112 * MiB, WS_WO = 120 * MiB;
constexpr size_t WS_H = 128 * MiB;
constexpr size_t WS_MEMN = 256 * MiB, WS_KM = 272 * MiB, WS_VT = 276 * MiB, WS_LOGF = 280 * MiB, WS_CL = 282 * MiB;
constexpr size_t WS_BIG = 284 * MiB;
constexpr size_t WS_UP = WS_BIG, WS_PD = WS_BIG + 32 * MiB, WS_QF = WS_BIG + 64 * MiB, WS_KF = WS_BIG + 128 * MiB, WS_VF = WS_BIG + 192 * MiB, WS_QM = WS_BIG + 256 * MiB, WS_GATE = WS_BIG + 288 * MiB;
constexpr size_t WS_END = WS_GATE + 384 * MiB;
constexpr size_t WS_BAR = 512 * 1024, WS_BAR_BYTES = 16384;
constexpr size_t WS_SSQ1 = 0, WS_SSQ2 = 256 * 1024;
constexpr size_t WS_H3 = WS_BIG + 352 * MiB;
static_assert(WS_BIG + (size_t)M_ * FF_ * 2 <= WS_END && WS_WO + 8 * MiB <= WS_H && WS_WIN + (size_t)NWIN * DM_ * 2 <= WS_WMKV, "d_ws map");
constexpr int RING_BYTES = 131072, LDS_BYTES = 147456;
static_assert(attn_body::ATTN_LDS_BYTES <= RING_BYTES && memattn::MEM_LDS_BYTES <= LDS_BYTES, "attention scratch fits");

#define GAS __attribute__((address_space(1)))
#define LAS __attribute__((address_space(3)))
typedef unsigned short bf16;
typedef unsigned v4u __attribute__((ext_vector_type(4)));
typedef unsigned v2u __attribute__((ext_vector_type(2)));
typedef float f32x4 __attribute__((ext_vector_type(4)));
#define LDS_WAIT() asm volatile("s_waitcnt lgkmcnt(0)" ::: "memory")
__device__ __forceinline__ unsigned f2bf(float f) { unsigned u = __builtin_bit_cast(unsigned, f); return (u + 0x7fffu + ((u >> 16) & 1u)) >> 16; }
__device__ __forceinline__ unsigned pk2(float lo, float hi) { return f2bf(lo) | (f2bf(hi) << 16); }
__device__ __forceinline__ float wave_sum(float v) {
#pragma unroll
    for (int o = 1; o < 64; o <<= 1) v += __shfl_xor(v, o);
    return v;
}
__device__ __forceinline__ int dmap(int map, int n) {
    if (map == 1) { const int up = n >= FF_ ? 1 : 0; const int c = up ? n - FF_ : n; return (c >> 7) * 256 + up * 128 + (c & 127); }
    if (map == 2) { return n < 3584 ? n : (n < 3600 ? 10240 + (n - 3584) : n - 16); }
    return n;
}
__device__ __forceinline__ float colscale(int map, int n) {
    if (map == 1) return n < FF_ ? LOG2E : (1.0f / LOG2E);
    if (map == 2) return n >= 4112 ? LOG2E : 1.0f;
    return 1.0f;
}
constexpr int TSCR = 64 * 65 * 4;
__device__ __forceinline__ void transpose_item(const float* W, int K, int N, bf16* WT, int map, LAS float* scr, int item, int lane, int ldk = 0, int koff = 0, const float* kgain = nullptr) {
    if (ldk == 0) ldk = K;
    const int nblk = (N + 63) / 64, kb = item / nblk, nb = item % nblk, k0 = 64 * kb, n0 = 64 * nb;
    const int kq = lane >> 4, c = lane & 15, nc = n0 + 4 * c; const bool okc = nc < N;
    f32x4 v[16];
    const float* src = W + (size_t)(k0 + kq) * N + nc;
#pragma unroll
    for (int i = 0; i < 16; ++i) v[i] = okc ? *(const f32x4*)(src + (size_t)(4 * i) * N) : (f32x4){0.f, 0.f, 0.f, 0.f};
#pragma unroll
    for (int i = 0; i < 16; ++i) { LAS float* d = scr + (4 * i + kq) * 65 + 4 * c; const float kg = kgain ? kgain[k0 + 4 * i + kq] : 1.0f;
        d[0] = v[i].x * kg; d[1] = v[i].y * kg; d[2] = v[i].z * kg; d[3] = v[i].w * kg; }
    LDS_WAIT(); asm volatile("" ::: "memory");
    const int cc = lane & 7, nn = lane >> 3;
#pragma unroll
    for (int j = 0; j < 8; ++j) { const int n = nn + 8 * j; const LAS float* s = scr + (8 * cc) * 65 + n; const float cs = colscale(map, n0 + n);
        v4u o; o.x = pk2(s[0 * 65] * cs, s[1 * 65] * cs); o.y = pk2(s[2 * 65] * cs, s[3 * 65] * cs); o.z = pk2(s[4 * 65] * cs, s[5 * 65] * cs); o.w = pk2(s[6 * 65] * cs, s[7 * 65] * cs);
        if (n0 + n < N) *(v4u*)(WT + (size_t)dmap(map, n0 + n) * ldk + koff + k0 + 8 * cc) = o; }
    LDS_WAIT(); asm volatile("" ::: "memory");
}
__device__ __forceinline__ int transpose_items(int K, int N) { return (K / 64) * ((N + 63) / 64); }
__device__ __forceinline__ void norm_row(const float* xrow, const float* gain, bf16* orow, int lane) {
    const f32x4* xr = (const f32x4*)xrow + lane; const f32x4* gr = (const f32x4*)gain + lane;
    f32x4 v[8]; float s = 0.f;
#pragma unroll
    for (int j = 0; j < 8; ++j) { v[j] = xr[64 * j]; s += (v[j].x * v[j].x + v[j].y * v[j].y) + (v[j].z * v[j].z + v[j].w * v[j].w); }
    const float r = 1.0f / sqrtf(wave_sum(s) * (1.0f / 2048.0f) + EPS_);
    v2u* o8 = (v2u*)orow + lane;
#pragma unroll
    for (int j = 0; j < 8; ++j) { const f32x4 g = gr[64 * j]; v2u w; w.x = pk2(v[j].x * r * g.x, v[j].y * r * g.y); w.y = pk2(v[j].z * r * g.z, v[j].w * r * g.w); o8[64 * j] = w; }
}
__device__ __forceinline__ void headnorm(bf16* X, int rows, int W, int HD, const float* gain, float scale, int gtid, int NT) {
    const int cpr = W / 8; const long total = (long)rows * cpr;
    for (long base = gtid; base < total; base += 4l * NT) {
        v4u v[4];
#pragma unroll
        for (int k = 0; k < 4; ++k) { const long idx = base + (long)k * NT; if (idx < total) v[k] = *(const v4u*)(X + idx * 8); }
#pragma unroll
        for (int k = 0; k < 4; ++k) { const long idx = base + (long)k * NT; if (idx < total) { const int ch = (int)(idx % cpr);
            float f[8] = {pg8::bf_lo(v[k].x), pg8::bf_hi(v[k].x), pg8::bf_lo(v[k].y), pg8::bf_hi(v[k].y), pg8::bf_lo(v[k].z), pg8::bf_hi(v[k].z), pg8::bf_lo(v[k].w), pg8::bf_hi(v[k].w)};
            float ss = 0.f;
#pragma unroll
            for (int j = 0; j < 8; ++j) ss += f[j] * f[j];
            ss += __shfl_xor(ss, 1); ss += __shfl_xor(ss, 2); ss += __shfl_xor(ss, 4); if (HD == 128) ss += __shfl_xor(ss, 8);
            const float r = scale / sqrtf(ss / (float)HD + EPS_);
            const float* g = gain + ((ch * 8) % HD);
            v4u o; o.x = pk2(f[0] * r * g[0], f[1] * r * g[1]); o.y = pk2(f[2] * r * g[2], f[3] * r * g[3]); o.z = pk2(f[4] * r * g[4], f[5] * r * g[5]); o.w = pk2(f[6] * r * g[6], f[7] * r * g[7]);
            *(v4u*)(X + idx * 8) = o; } } }
}

#define XB_TMO      128
#define XB_XCNT(j)  (256  + 64 * (j))
#define XB_XSUB(j)  (1280 + 64 * (j))
#define XB_XGEN(j)  (2304 + 64 * (j))
#define XB_TOP      3328
#define XB_TOPGEN   3392
#define XCD_BAR_WORDS 3456
#define XB_SPIN_CAP (1u << 18)

__device__ __forceinline__ unsigned xb_ld(unsigned* p)              { return __hip_atomic_load(p, __ATOMIC_RELAXED, __HIP_MEMORY_SCOPE_AGENT); }
__device__ __forceinline__ unsigned xb_add(unsigned* p, unsigned v) { return __hip_atomic_fetch_add(p, v, __ATOMIC_RELAXED, __HIP_MEMORY_SCOPE_AGENT); }
__device__ __forceinline__ unsigned xb_xcc_id() { return (unsigned)__builtin_amdgcn_s_getreg((3 << 11) | 20) & 0xFu; }
#define XB_SPIN(cond, bar) do { unsigned _sp = 0; while (cond) { __builtin_amdgcn_s_sleep(1); \
    if ((++_sp & 255u) == 0u) { if (xb_ld(&(bar)[XB_TMO])) break; if (_sp > XB_SPIN_CAP) { atomicAdd(&(bar)[XB_TMO], 1u); break; } } } } while (0)

struct XcdBarrier {
    unsigned* bar; unsigned x;
    volatile LAS unsigned* st;
};

__device__ __forceinline__ XcdBarrier xcd_barrier_post(unsigned* bar, volatile LAS unsigned* st) {
    XcdBarrier b; b.bar = bar; b.x = xb_xcc_id(); b.st = st;
    if (threadIdx.x == 0) (void)xb_add(&bar[XB_XCNT(b.x)], 1u);
    return b;
}
__device__ __forceinline__ void xcd_barrier_complete(unsigned* bar, unsigned x, unsigned& nloc, unsigned& nx) {
    const unsigned G = gridDim.x * gridDim.y * gridDim.z;
    unsigned sum, cnt, mine, sp = 0u;
    for (;;) {
        sum = 0u; cnt = 0u; mine = 0u;
#pragma unroll
        for (unsigned j = 0; j < 16; ++j) { const unsigned c = xb_ld(&bar[XB_XCNT(j)]); sum += c; cnt += (c > 0u) ? 1u : 0u; mine = (j == x) ? c : mine; }
        if (sum == G) break;
        __builtin_amdgcn_s_sleep(1);
        if ((++sp & 255u) == 0u) { if (xb_ld(&bar[XB_TMO])) break; if (sp > XB_SPIN_CAP) { atomicAdd(&bar[XB_TMO], 1u); break; } }
    }
    nloc = mine > 0u ? mine : 1u; nx = cnt > 0u ? cnt : 1u;
}

__device__ __forceinline__ void xcd_barrier(const XcdBarrier& b) {
    asm volatile("s_waitcnt vmcnt(0)" ::: "memory");
    __syncthreads();
    if (threadIdx.x == 0) {
        unsigned* bar = b.bar;
        __builtin_amdgcn_s_waitcnt(0);
        unsigned nloc = b.st[0], nx = b.st[1];
        if (nloc == 0u) { xcd_barrier_complete(bar, b.x, nloc, nx); b.st[0] = nloc; b.st[1] = nx; }
        const unsigned old = xb_add(&bar[XB_XSUB(b.x)], 1u);
        const unsigned gen = old / nloc;
        if (old + 1u == (gen + 1u) * nloc) {
            __builtin_amdgcn_fence(__ATOMIC_RELEASE, "agent");
            asm volatile("s_waitcnt vmcnt(0)" ::: "memory");
            const unsigned og = xb_add(&bar[XB_TOP], 1u);
            const unsigned tg = og / nx;
            if (og + 1u == (tg + 1u) * nx) xb_add(&bar[XB_TOPGEN], 1u);
            else XB_SPIN(xb_ld(&bar[XB_TOPGEN]) == tg, bar);
            __builtin_amdgcn_fence(__ATOMIC_ACQUIRE, "agent");
            xb_add(&bar[XB_XGEN(b.x)], 1u);
            asm volatile("s_waitcnt vmcnt(0)" ::: "memory");
        } else {
            XB_SPIN(xb_ld(&bar[XB_XGEN(b.x)]) == gen, bar);
            __builtin_amdgcn_fence(__ATOMIC_ACQUIRE, "agent");
            asm volatile("s_waitcnt vmcnt(0)" ::: "memory");
        }
    }
    __syncthreads();
}

struct Args { const float* in[23]; float* out; unsigned char* ws; int ph_lo, ph_hi; };

__global__ void __launch_bounds__(NWAVES * 64, 2) mk_fwd(Args args) {
    __builtin_assume(__builtin_amdgcn_workitem_id_y() == 0); __builtin_assume(__builtin_amdgcn_workitem_id_z() == 0);
    extern __shared__ __attribute__((aligned(16))) unsigned char lds[];
    LAS unsigned char* L = (LAS unsigned char*)lds;
    const int tid = threadIdx.x, lane = tid & 63, wave = __builtin_amdgcn_readfirstlane(tid >> 6);
    const int G = gridDim.x, bx = blockIdx.x, vcu = (G % 8 == 0) ? (bx % 8) * (G / 8) + bx / 8 : bx;
    const int gw = vcu * NWAVES + wave, NGW = G * NWAVES, gtid = gw * 64 + lane, NT = NGW * 64;
    unsigned char* ws = args.ws;
    if (tid < 16) ((LAS unsigned*)(L + LDS_BYTES - 64))[tid] = 0u;
    __syncthreads();
    const XcdBarrier gbar = xcd_barrier_post((unsigned*)(ws + WS_BAR), (volatile LAS unsigned*)(L + LDS_BYTES - 64));
    LAS float* scr = (LAS float*)(L + wave * TSCR);

    const int lo = args.ph_lo, hi = args.ph_hi;
#define IN(k) (lo <= (k) && (k) < hi)
#define SEAM(k) do { if ((k) + 1 < hi) { xcd_barrier(gbar); } } while (0)
#define GEMM(EPI, g, E, crot) do { pg8::StaticOrder S_; S_.init((g).M, (g).N, G, (bx + (crot)) % G); pg8::gemm_phase<EPI, pg8::StaticOrder, true, true>(L, g, S_, E); } while (0)

    if (IN(0)) {
        const int i0 = transpose_items(2048, 11264), i1 = transpose_items(5632, 2048), i2 = transpose_items(2048, NWIN_SRC), i3 = transpose_items(1024, 2048), i4 = transpose_items(2048, 1024),
                  i5 = transpose_items(512, 2048), i6 = transpose_items(2048, 2048);
        const int total = i0 + i1 + i2 + i3 + i4 + i5 + i6;
        for (int it = gw; it < total; it += NGW) { int r = it;
            if (r < i0) { transpose_item(args.in[3], 2048, 11264, (bf16*)(ws + WS_GU), 1, scr, r, lane); continue; } r -= i0;
            if (r < i1) { transpose_item(args.in[4], 5632, 2048, (bf16*)(ws + WS_DN), 0, scr, r, lane); continue; } r -= i1;
            if (r < i2) { transpose_item(args.in[7], 2048, NWIN_SRC, (bf16*)(ws + WS_WIN), 2, scr, r, lane, 0, 0, args.in[5]); continue; } r -= i2;
            if (r < i3) { transpose_item(args.in[14], 1024, 2048, (bf16*)(ws + WS_WCAT), 0, scr, r, lane, 2048, 512); continue; } r -= i3;
            if (r < i4) { transpose_item(args.in[15], 2048, 1024, (bf16*)(ws + WS_WMKV), 0, scr, r, lane); continue; } r -= i4;
            if (r < i5) { transpose_item(args.in[18], 512, 2048, (bf16*)(ws + WS_WCAT), 0, scr, r, lane, 2048, 1536); continue; } r -= i5;
            transpose_item(args.in[19], 2048, 2048, (bf16*)(ws + WS_WO), 0, scr, r, lane); }
        for (int i = gtid; i < 2 * M_; i += NT) { ((float*)(ws + WS_SSQ1))[i < M_ ? i : i - M_ + (int)((WS_SSQ2 - WS_SSQ1) / 4)] = 0.f; }
        for (int i = gtid; i < 240 * 256; i += NT) *(v4u*)(ws + WS_WIN + (size_t)10256 * 4096 + (size_t)i * 16) = (v4u){0u, 0u, 0u, 0u};
        { const float* pw = args.in[9]; const float* ps = args.in[10]; const float* wpu = args.in[11]; bf16* WP = (bf16*)(ws + WS_WCAT);
          for (int it = gw; it < 2048; it += NGW) { const int nb = it >> 6, cc = it & 63, g = cc >> 4, c0 = (cc & 15) * 8, n = nb * 64 + lane;
            float a0 = 0.f, a1 = 0.f, a2 = 0.f, a3 = 0.f, a4 = 0.f, a5 = 0.f, a6 = 0.f, a7 = 0.f;
            const float* pr = pw + (size_t)(g * 128 + c0) * 128;
#pragma unroll 16
            for (int d = 0; d < 128; ++d) { const float wv = ps[g * 128 + d] * wpu[(size_t)(g * 128 + d) * 2048 + n];
                a0 += pr[d] * wv; a1 += pr[128 + d] * wv; a2 += pr[256 + d] * wv; a3 += pr[384 + d] * wv; a4 += pr[512 + d] * wv; a5 += pr[640 + d] * wv; a6 += pr[768 + d] * wv; a7 += pr[896 + d] * wv; }
            v4u o; o.x = pk2(a0, a1); o.y = pk2(a2, a3); o.z = pk2(a4, a5); o.w = pk2(a6, a7);
            *(v4u*)(WP + (size_t)n * 2048 + cc * 8) = o; } }
        for (int m = gw; m < M_; m += NGW) norm_row(args.in[0] + (size_t)m * 2048, args.in[2], (bf16*)(ws + WS_H) + (size_t)m * 2048, lane);
        for (int m = gw; m < MM_; m += NGW) norm_row(args.in[1] + (size_t)m * 2048, args.in[6], (bf16*)(ws + WS_MEMN) + (size_t)m * 2048, lane);
        SEAM(0);
    }
    if (IN(1)) {
        __syncthreads();
        { const pg8::Gemm g{(const bf16*)(ws + WS_H), (const bf16*)(ws + WS_GU), M_, 2 * FF_, 2048}; const pg8::EpiSwiGLU E{(bf16*)(ws + WS_BIG), FF_, nullptr}; GEMM(pg8::EpiSwiGLU, g, E, 0); }
        SEAM(1);
    }
    if (IN(2)) {
        __syncthreads();
        { const pg8::Gemm g{(const bf16*)(ws + WS_BIG), (const bf16*)(ws + WS_DN), M_, 2048, FF_}; const pg8::EpiResid E{args.in[0], nullptr, nullptr, (bf16*)(ws + WS_H), (float*)(ws + WS_SSQ1), 2048, 0.5f}; GEMM(pg8::EpiResid, g, E, 0); }
        SEAM(2);
    }
    if (IN(4)) {
        __syncthreads();
        { const pg8::Gemm g{(const bf16*)(ws + WS_H), (const bf16*)(ws + WS_WIN), M_, NWIN, 2048};
          const pg8::EpiWin E{(bf16*)(ws + WS_UP), (bf16*)(ws + WS_QF), (bf16*)(ws + WS_KF), (bf16*)(ws + WS_VF), (bf16*)(ws + WS_QM), (bf16*)(ws + WS_GATE), (float*)(ws + WS_LOGF), args.in[8], (const float*)(ws + WS_SSQ1), args.in[12], args.in[13], args.in[16], (LAS float*)(L + RING_BYTES)};
          GEMM(pg8::EpiWin, g, E, 0); }
        { const pg8::Gemm g{(const bf16*)(ws + WS_MEMN), (const bf16*)(ws + WS_WMKV), MM_, 512, 2048}; const pg8::EpiBf16<0> E{(bf16*)(ws + WS_KM), 512, nullptr, 0, 0, 1.f}; GEMM(pg8::EpiBf16<0>, g, E, G / 2); }
        { const pg8::Gemm g{(const bf16*)(ws + WS_WMKV) + (size_t)512 * 2048, (const bf16*)(ws + WS_MEMN), 512, MM_, 2048}; const pg8::EpiBf16<0> E{(bf16*)(ws + WS_VT), MM_, nullptr, 0, 0, 1.f}; GEMM(pg8::EpiBf16<0>, g, E, (3 * G) / 8); }
        if (bx >= (3 * G) / 4) { const int gw2 = (bx - (3 * G) / 4) * NWAVES + wave, NGW2 = (G - (3 * G) / 4) * NWAVES;
          const int i0 = transpose_items(2048, 11264), i1 = transpose_items(5632, 2048);
          for (int it = gw2; it < i0 + i1; it += NGW2) {
            if (it < i0) transpose_item(args.in[21], 2048, 11264, (bf16*)(ws + WS_GU), 1, scr, it, lane, 0, 0, args.in[20]);
            else transpose_item(args.in[22], 5632, 2048, (bf16*)(ws + WS_DN), 0, scr, it - i0, lane); } }
        SEAM(4);
    }
    if (IN(6)) {
        { const bf16* UP = (const bf16*)(ws + WS_UP); bf16* PD = (bf16*)args.out;
          for (int it = gtid; it < (M_ / 8) * 64; it += NT) { const int cc = it & 63, m0 = (it >> 6) * 8, t0 = m0 & (S_ - 1), w = 2 << (cc >> 4);
            const bf16* up = UP + (size_t)m0 * 512 + cc * 8;
            v4u hv[15], cv[8];
#pragma unroll
            for (int j = 0; j < 15; ++j) { hv[j] = (v4u){0u, 0u, 0u, 0u}; if (j + 1 < w && t0 >= j + 1) hv[j] = *(const v4u*)(up - (size_t)(j + 1) * 512); }
#pragma unroll
            for (int r = 0; r < 8; ++r) cv[r] = *(const v4u*)(up + (size_t)r * 512);
#pragma unroll
            for (int r = 0; r < 8; ++r) { float s0 = 0.f, s1 = 0.f, s2 = 0.f, s3 = 0.f, s4 = 0.f, s5 = 0.f, s6 = 0.f, s7 = 0.f;
#pragma unroll
                for (int j = 0; j < 16; ++j) { if (j <= r + 15) { const v4u v = (r - j >= 0) ? cv[(r - j >= 0) ? r - j : 0] : hv[(j - r - 1 >= 0 && j - r - 1 < 15) ? j - r - 1 : 0];
                    if (j < w) { s0 += pg8::bf_lo(v.x); s1 += pg8::bf_hi(v.x); s2 += pg8::bf_lo(v.y); s3 += pg8::bf_hi(v.y); s4 += pg8::bf_lo(v.z); s5 += pg8::bf_hi(v.z); s6 += pg8::bf_lo(v.w); s7 += pg8::bf_hi(v.w); } } }
                const int tt = t0 + r + 1; const float rn = 1.0f / (float)(tt < w ? tt : w); const v4u c = cv[r];
                v4u o; o.x = pk2(s0 * rn - pg8::bf_lo(c.x), s1 * rn - pg8::bf_hi(c.x)); o.y = pk2(s2 * rn - pg8::bf_lo(c.y), s3 * rn - pg8::bf_hi(c.y));
                o.z = pk2(s4 * rn - pg8::bf_lo(c.z), s5 * rn - pg8::bf_hi(c.z)); o.w = pk2(s6 * rn - pg8::bf_lo(c.w), s7 * rn - pg8::bf_hi(c.w));
                *(v4u*)(PD + (size_t)(m0 + r) * 2048 + cc * 8) = o; } } }
        __syncthreads();
        { const attn_body::AttnTensors AT{(const attn_body::bf16*)(ws + WS_QF), (const attn_body::bf16*)(ws + WS_KF), (const attn_body::bf16*)(ws + WS_VF), (attn_body::bf16*)args.out + 512, (const float*)(ws + WS_LOGF)};
          const attn_body::StaticOrder S(G, vcu);
          attn_body::attn_phase<attn_body::StaticOrder, 40>((char*)lds, AT, S); }
        __syncthreads();
        for (int p = vcu; p < B_ * 4 * 4; p += G) { const int b = p >> 4, hm = (p >> 2) & 3;
            memattn::stage_kv(b, hm, (const bf16*)(ws + WS_KM), (const bf16*)(ws + WS_VT), args.in[17], L);
            __syncthreads();
            memattn::unit(b, hm, (p & 3) * 2, (const bf16*)(ws + WS_QM), (bf16*)args.out + 1536, L);
            memattn::unit(b, hm, (p & 3) * 2 + 1, (const bf16*)(ws + WS_QM), (bf16*)args.out + 1536, L);
            __syncthreads(); }
        SEAM(6);
    }
    if (IN(7)) {
        __syncthreads();
        { const pg8::Gemm g{(const bf16*)args.out, (const bf16*)(ws + WS_WCAT), M_, 2048, 2048}; const pg8::EpiGate E{(bf16*)(ws + WS_QF), (const bf16*)(ws + WS_GATE)}; GEMM(pg8::EpiGate, g, E, 0); }
        SEAM(7);
    }
    if (IN(8)) {
        __syncthreads();
        { const pg8::Gemm g{(const bf16*)(ws + WS_QF), (const bf16*)(ws + WS_WO), M_, 2048, 2048}; const pg8::EpiResid E{nullptr, (const bf16*)(ws + WS_H), nullptr, (bf16*)(ws + WS_H3), (float*)(ws + WS_SSQ2), 2048, 1.0f}; GEMM(pg8::EpiResid, g, E, 0); }
        SEAM(8);
    }
    if (IN(10)) {
        __syncthreads();
        { const pg8::Gemm g{(const bf16*)(ws + WS_H3), (const bf16*)(ws + WS_GU), M_, 2 * FF_, 2048}; const pg8::EpiSwiGLU E{(bf16*)(ws + WS_BIG), FF_, (const float*)(ws + WS_SSQ2)}; GEMM(pg8::EpiSwiGLU, g, E, 0); }
        SEAM(10);
    }
    if (IN(11)) {
        __syncthreads();
        { const pg8::Gemm g{(const bf16*)(ws + WS_BIG), (const bf16*)(ws + WS_DN), M_, 2048, FF_}; const pg8::EpiResid E{nullptr, (const bf16*)(ws + WS_H3), args.out, nullptr, nullptr, 2048, 0.5f}; GEMM(pg8::EpiResid, g, E, 0); }
    }
    if (hi > 4096) cg::this_grid().sync();
#undef IN
#undef SEAM
#undef GEMM
}

extern "C" void kernel_launch(void* const* d_in, const int* in_sizes, int n_in, void* d_out, int out_size, void* d_ws, size_t ws_size, hipStream_t stream) {
    static int grid = 0;
    if (grid == 0) {
        if (n_in != 23 || in_sizes[0] != M_ * DM_ || out_size != M_ * DM_ || ws_size < WS_END) { fprintf(stderr, "kernel_launch: unexpected problem (n_in %d, ws %zu < %zu?); nothing launched\n", n_in, ws_size, (size_t)WS_END); grid = -1; return; }
        int dev = 0, cus = 0, per_cu = 0;
        if (hipGetDevice(&dev) != hipSuccess || hipDeviceGetAttribute(&cus, hipDeviceAttributeMultiprocessorCount, dev) != hipSuccess) { grid = -1; return; }
        if (hipFuncSetAttribute((const void*)mk_fwd, hipFuncAttributeMaxDynamicSharedMemorySize, LDS_BYTES) != hipSuccess) { fprintf(stderr, "kernel_launch: hipFuncSetAttribute failed\n"); grid = -1; return; }
        if (hipOccupancyMaxActiveBlocksPerMultiprocessor(&per_cu, (const void*)mk_fwd, NWAVES * 64, LDS_BYTES) != hipSuccess || per_cu < 1) { fprintf(stderr, "kernel_launch: occupancy query says %d\n", per_cu); per_cu = 1; }
        (void)hipGetLastError();
        grid = cus * per_cu;
    }
    if (grid < 0) return;
    (void)hipMemsetAsync((unsigned char*)d_ws + WS_BAR, 0, WS_BAR_BYTES, stream);
    Args a{};
    for (int i = 0; i < 23; ++i) a.in[i] = (const float*)d_in[i];
    a.out = (float*)d_out; a.ws = (unsigned char*)d_ws;
#if MK_N_LAUNCHES == 1
    a.ph_lo = 0; a.ph_hi = NPH;
    void* kargs[] = {&a};
    hipError_t e = hipLaunchCooperativeKernel((const void*)mk_fwd, dim3(grid), dim3(NWAVES * 64), kargs, LDS_BYTES, stream);
    if (e != hipSuccess) fprintf(stderr, "kernel_launch: cooperative launch failed: %s (grid %d)\n", hipGetErrorString(e), grid);
#elif MK_N_LAUNCHES == 112
    for (int ph = 0; ph < NPH; ++ph) { a.ph_lo = ph; a.ph_hi = ph + 1; void* kargs[] = {&a}; (void)hipLaunchCooperativeKernel((const void*)mk_fwd, dim3(grid), dim3(NWAVES * 64), kargs, LDS_BYTES, stream); }
#else
    for (int ph = 0; ph < NPH; ++ph) { a.ph_lo = ph; a.ph_hi = ph + 1; for (int rep = 0; rep < (((PROBE_DOUBLE_MASK) >> ph) & 1) + 1; ++rep) hipLaunchKernelGGL(mk_fwd, dim3(grid), dim3(NWAVES * 64), LDS_BYTES, stream, a); }
#endif
}
```

```cpp
#define MK_N_LAUNCHES 1
#include <hip/hip_runtime.h>
#include <hip/hip_cooperative_groups.h>
namespace cg = cooperative_groups;
#include <hip/hip_runtime.h>
#include <cstdio>
#include <cstdint>
namespace pg8 {
#define PG8_LAS __attribute__((address_space(3)))
typedef unsigned short bf16_t;
typedef short bf16x8 __attribute__((ext_vector_type(8)));
typedef float f32x4 __attribute__((ext_vector_type(4)));
typedef unsigned u32x4 __attribute__((ext_vector_type(4)));
constexpr int BM = 256, BK = 64, HALF = 128, HTB = HALF * BK * 2  , STAGE_BYTES = 8 * HTB, NXCD = 8, WGM = 8;

__host__ __device__ __forceinline__ int lds_byte(int r, int c) { const int st = (r >> 4) * 2 + (c >> 5), rr = r & 15, cc = c & 31, ob = rr * 64 + cc * 2; return st * 1024 + (ob ^ (((ob >> 9) & 1) << 5)); }
__host__ __device__ __forceinline__ void stage_rc(int b, int& R, int& C) { const int st = b / 1024, sb = b % 1024, swz = sb ^ (((sb >> 9) & 1) << 5); R = (st >> 1) * 16 + swz / 64; C = (st & 1) * 32 + (swz % 64) / 2; }
__host__ __device__ __forceinline__ int perm32(int rho) { const int n = rho >> 4, i = rho & 15; return 8 * (i >> 2) + 4 * n + (i & 3); }

struct Unit { int pm, pn; };
struct Gemm { const bf16_t* A; const bf16_t* Bt; int M, N, K; };

struct StaticOrder {
    int nM, nN, nwg, G, c;
    __host__ __device__ void init(int M, int N, int G_, int c_) { nM = M / BM; nN = N / BM; nwg = nM * nN; G = G_; c = c_; }
    __host__ __device__ bool next(int i, Unit& u) const {
        const long L = (long)i * G + c; if (L >= nwg) return false;
        int wgid = (int)L; { const int q = nwg / NXCD, r = nwg % NXCD, xcd = wgid % NXCD, off = wgid / NXCD; wgid = (xcd < r ? xcd * (q + 1) : r * (q + 1) + (xcd - r) * q) + off; }
        const int nig = WGM * nN, gid = wgid / nig, fm = gid * WGM, gsz = (nM - fm) < WGM ? (nM - fm) : WGM;
        u.pm = fm + ((wgid % nig) % gsz); u.pn = (wgid % nig) / gsz; return true;
    }
    __device__ __forceinline__ void a_ready(const Unit&) const {}
    __device__ __forceinline__ void done(const Unit&) const {}
};

__device__ __forceinline__ unsigned cvt_pk_bf16(float lo, float hi) { unsigned r; asm volatile("v_cvt_pk_bf16_f32 %0, %1, %2" : "=v"(r) : "v"(lo), "v"(hi)); return r; }
typedef float f32x2 __attribute__((ext_vector_type(2)));
__device__ __forceinline__ f32x2 gelu_pk(f32x2 v) {
    const f32x2 av = __builtin_elementwise_abs(v), d = av * 0.2316418882f + 1.0f;
    f32x2 t; t.x = __builtin_amdgcn_rcpf(d.x); t.y = __builtin_amdgcn_rcpf(d.y);
    f32x2 q = t * 0.5307027145f + (-0.7265760135f); q = q * t + 0.7107068705f; q = q * t + (-0.142248368f); q = q * t + 0.127414796f; q = q * t;
    const f32x2 s = (v * v) * (-0.72134752044f);
    f32x2 e; e.x = __builtin_amdgcn_exp2f(s.x); e.y = __builtin_amdgcn_exp2f(s.y);
    const f32x2 m = v * (q * e), r = v - m;
    f32x2 o; o.x = v.x < 0.f ? m.x : r.x; o.y = v.y < 0.f ? m.y : r.y; return o;
}

template <int ACT  > struct EpiBf16 {
    static constexpr bool PERM = true, AFTER_DRAIN = false, HOOK = false, CTX = false; static constexpr int H1 = -1, H2 = -1; static_assert(ACT == 0 || ACT == 1, "EpiBf16: ACT is 0 (none) or 1 (gelu_pk)");
    bf16_t* O; int ldc; const float* bias; int split_cols; size_t split_stride; float scale0;
    __device__ __forceinline__ void operator()(const f32x4 (&acc)[2][2][4][2], const Unit& u, int wr, int wc, int fr, int fq) const {
        const int row0 = u.pm * BM + wr * 64 + fr; int colt = u.pn * BM; bf16_t* base = O;
        float sc = 1.f; if (split_cols) { const int t = colt / split_cols; base += (size_t)t * split_stride; colt -= t * split_cols; if (t == 0) sc = scale0; }
        const int col0 = colt + wc * 32 + 8 * fq, bcol0 = u.pn * BM + wc * 32 + 8 * fq;
        f32x4 bv[2][2];
#pragma unroll
        for (int bj = 0; bj < 2; ++bj)
#pragma unroll
            for (int n = 0; n < 2; ++n) bv[bj][n] = bias ? *(const f32x4*)(bias + bcol0 + bj * HALF + 4 * n) : (f32x4){0.f, 0.f, 0.f, 0.f};
#pragma unroll
        for (int ai = 0; ai < 2; ++ai)
#pragma unroll
            for (int m = 0; m < 4; ++m) { bf16_t* rowp = base + (size_t)(row0 + ai * HALF + m * 16) * ldc + col0;
#pragma unroll
                for (int bj = 0; bj < 2; ++bj) { f32x4 v0 = acc[ai][bj][m][0] + bv[bj][0], v1 = acc[ai][bj][m][1] + bv[bj][1];
                    if (ACT == 1) { f32x2 a = gelu_pk((f32x2){v0[0], v0[1]}), b = gelu_pk((f32x2){v0[2], v0[3]}), c = gelu_pk((f32x2){v1[0], v1[1]}), d = gelu_pk((f32x2){v1[2], v1[3]});
                        v0 = (f32x4){a.x, a.y, b.x, b.y}; v1 = (f32x4){c.x, c.y, d.x, d.y}; }
                    v0 = v0 * sc; v1 = v1 * sc; u32x4 w; w.x = cvt_pk_bf16(v0[0], v0[1]); w.y = cvt_pk_bf16(v0[2], v0[3]); w.z = cvt_pk_bf16(v1[0], v1[1]); w.w = cvt_pk_bf16(v1[2], v1[3]);
                    *(u32x4*)(rowp + bj * HALF) = w; } }
    }
};
__device__ __forceinline__ float sigm_f(float g) { return __builtin_amdgcn_rcpf(1.0f + __builtin_amdgcn_exp2f(-1.4426950408889634f * g)); }
__device__ __forceinline__ float silu_f(float g) { return g * sigm_f(g); }
__device__ __forceinline__ float sigm2_f(float x) { return __builtin_amdgcn_rcpf(1.0f + __builtin_amdgcn_exp2f(-x)); }
__device__ __forceinline__ float gate_f(float x) { return fmaxf(sigm2_f(x), 1e-18f); }
__device__ __forceinline__ float bf_lo(unsigned w) { return __uint_as_float(w << 16); }
__device__ __forceinline__ float bf_hi(unsigned w) { return __uint_as_float(w & 0xffff0000u); }
__device__ __forceinline__ float logsig_f(float x) { return fminf(x, 0.f) - 0.6931471805599453f * __builtin_amdgcn_logf(1.0f + __builtin_amdgcn_exp2f(-1.4426950408889634f * fabsf(x))); }

struct EpiSwiGLU {
    static constexpr bool PERM = true, AFTER_DRAIN = false, HOOK = false, CTX = true;
    bf16_t* O; int ldc; const float* ssq;
    __device__ __forceinline__ void run(const f32x4 (&acc)[2][2][4][2], const Unit& u, int wr, int wc, int fr, int fq, float (&rc)[8], int& cpm) const {
        const int row0 = u.pm * BM + wr * 64 + fr, col0 = u.pn * HALF + wc * 32 + 8 * fq;
        if (ssq && u.pm != cpm) { cpm = u.pm;
#pragma unroll
            for (int k = 0; k < 8; ++k) rc[k] = 1.0f / sqrtf(ssq[row0 + (k >> 2) * HALF + (k & 3) * 16] * (1.0f / 2048.0f) + 1e-6f); }
#pragma unroll
        for (int ai = 0; ai < 2; ++ai)
#pragma unroll
            for (int m = 0; m < 4; ++m) { bf16_t* p = O + (size_t)(row0 + ai * HALF + m * 16) * ldc + col0;
                const float rs = rc[ai * 4 + m];
                const f32x4 g0 = acc[ai][0][m][0] * rs, g1 = acc[ai][0][m][1] * rs, u0 = acc[ai][1][m][0] * rs, u1 = acc[ai][1][m][1] * rs;
                u32x4 w; w.x = cvt_pk_bf16(g0[0] * sigm2_f(g0[0]) * u0[0], g0[1] * sigm2_f(g0[1]) * u0[1]); w.y = cvt_pk_bf16(g0[2] * sigm2_f(g0[2]) * u0[2], g0[3] * sigm2_f(g0[3]) * u0[3]);
                w.z = cvt_pk_bf16(g1[0] * sigm2_f(g1[0]) * u1[0], g1[1] * sigm2_f(g1[1]) * u1[1]); w.w = cvt_pk_bf16(g1[2] * sigm2_f(g1[2]) * u1[2], g1[3] * sigm2_f(g1[3]) * u1[3]);
                *(u32x4*)p = w; }
    }
};
struct EpiResid {
    static constexpr bool PERM = true, AFTER_DRAIN = false, HOOK = false, CTX = false; static constexpr int H1 = -1, H2 = -1;
    const float* basef; const bf16_t* baseb; float* outf; bf16_t* outb; float* ssq; int ldc; float alpha;
    __device__ __forceinline__ void operator()(const f32x4 (&acc)[2][2][4][2], const Unit& u, int wr, int wc, int fr, int fq) const {
        const int col0 = u.pn * BM + wc * 32 + 8 * fq;
#pragma unroll
        for (int ai = 0; ai < 2; ++ai) {
            f32x4 bf0[4][2], bf1[4][2]; u32x4 bq[4][2]; float keep = 0.f;
#pragma unroll
            for (int m = 0; m < 4; ++m)
#pragma unroll
                for (int bj = 0; bj < 2; ++bj) { const size_t idx = (size_t)(u.pm * BM + ai * HALF + wr * 64 + m * 16 + fr) * ldc + col0 + bj * HALF;
                    if (basef) { bf0[m][bj] = *(const f32x4*)(basef + idx); bf1[m][bj] = *(const f32x4*)(basef + idx + 4); } else bq[m][bj] = *(const u32x4*)(baseb + idx); }
#pragma unroll
            for (int m = 0; m < 4; ++m) { const int row = u.pm * BM + ai * HALF + wr * 64 + m * 16 + fr; const size_t off = (size_t)row * ldc + col0; float ss = 0.f;
#pragma unroll
                for (int bj = 0; bj < 2; ++bj) { const size_t idx = off + bj * HALF; f32x4 b0, b1;
                    if (basef) { b0 = bf0[m][bj]; b1 = bf1[m][bj]; }
                    else { const u32x4 q = bq[m][bj]; b0 = (f32x4){bf_lo(q.x), bf_hi(q.x), bf_lo(q.y), bf_hi(q.y)}; b1 = (f32x4){bf_lo(q.z), bf_hi(q.z), bf_lo(q.w), bf_hi(q.w)}; }
                    const f32x4 v0 = b0 + acc[ai][bj][m][0] * alpha, v1 = b1 + acc[ai][bj][m][1] * alpha;
                    if (outf) { *(f32x4*)(outf + idx) = v0; *(f32x4*)(outf + idx + 4) = v1; }
                    if (outb) { u32x4 w; w.x = cvt_pk_bf16(v0[0], v0[1]); w.y = cvt_pk_bf16(v0[2], v0[3]); w.z = cvt_pk_bf16(v1[0], v1[1]); w.w = cvt_pk_bf16(v1[2], v1[3]); *(u32x4*)(outb + idx) = w; }
                    ss += ((v0[0] * v0[0] + v0[1] * v0[1]) + (v0[2] * v0[2] + v0[3] * v0[3])) + ((v1[0] * v1[0] + v1[1] * v1[1]) + (v1[2] * v1[2] + v1[3] * v1[3])); }
                if (ssq) { ss += __shfl_xor(ss, 16); ss += __shfl_xor(ss, 32); if (m == fq) keep = ss; } }
            if (ssq) (void)__hip_atomic_fetch_add(ssq + (u.pm * BM + ai * HALF + wr * 64 + fq * 16 + fr), keep, __ATOMIC_RELAXED, __HIP_MEMORY_SCOPE_AGENT); }
    }
};
struct EpiWin {
    static constexpr bool PERM = true, AFTER_DRAIN = false, HOOK = false, CTX = true; static constexpr int H1 = -1, H2 = -1;
    bf16_t *UP, *QF, *KF, *VF, *QM, *GATE; float* LOGF; const float* bfg; const float* ssq; const float *gq, *gk, *gm; PG8_LAS float* X;
    __device__ __forceinline__ void run(const f32x4 (&acc)[2][2][4][2], const Unit& u, int wr, int wc, int fr, int fq, float (&rc)[8], int& cpm) const {
        const int pn = u.pn, row0 = u.pm * BM + wr * 64 + fr;
        if (u.pm != cpm) { cpm = u.pm;
#pragma unroll
            for (int k = 0; k < 8; ++k) rc[k] = 1.0f / sqrtf(ssq[row0 + (k >> 2) * HALF + (k & 3) * 16] * (1.0f / 2048.0f) + 1e-6f); }
        if (pn == 40) {
            if (wc == 0 && fq < 2) {
                const f32x4 b0 = *(const f32x4*)(bfg + 8 * fq), b1 = *(const f32x4*)(bfg + 8 * fq + 4);
#pragma unroll
                for (int ai = 0; ai < 2; ++ai)
#pragma unroll
                    for (int m = 0; m < 4; ++m) { float* p = LOGF + (size_t)(row0 + ai * HALF + m * 16) * 16 + 8 * fq;
                        const float rs = rc[ai * 4 + m];
                        const f32x4 v0 = acc[ai][0][m][0] * rs + b0, v1 = acc[ai][0][m][1] * rs + b1;
                        *(f32x4*)p = (f32x4){logsig_f(v0[0]), logsig_f(v0[1]), logsig_f(v0[2]), logsig_f(v0[3])};
                        *(f32x4*)(p + 4) = (f32x4){logsig_f(v1[0]), logsig_f(v1[1]), logsig_f(v1[2]), logsig_f(v1[3])}; }
            }
            return;
        }
        bf16_t* O; int ldc, colt; bool sg = false; int hn = 0; const float* gain = nullptr; float hscale = 1.f;
        if (pn < 2) { O = UP; ldc = 512; colt = pn * BM; } else if (pn < 6) { O = QF; ldc = 1024; colt = (pn - 2) * BM; hn = 1; gain = gq; hscale = 0.125f * 1.4426950408889634f; }
        else if (pn < 10) { O = KF; ldc = 1024; colt = (pn - 6) * BM; hn = 1; gain = gk; }
        else if (pn < 14) { O = VF; ldc = 1024; colt = (pn - 10) * BM; } else if (pn < 16) { O = QM; ldc = 512; colt = (pn - 14) * BM; hn = 2; gain = gm; hscale = 0.08838834764831845f * 1.4426950408889634f; }
        else { O = GATE; ldc = 6144; colt = (pn - 16) * BM; sg = true; }
        const int col0 = colt + wc * 32 + 8 * fq;
        float rsv[2][4];
#pragma unroll
        for (int ai = 0; ai < 2; ++ai)
#pragma unroll
            for (int m = 0; m < 4; ++m) rsv[ai][m] = rc[ai * 4 + m];
        if (hn) {
#pragma unroll
            for (int ai = 0; ai < 2; ++ai)
#pragma unroll
                for (int m = 0; m < 4; ++m) { const int rowl = ai * HALF + wr * 64 + m * 16 + fr; const float rs = rsv[ai][m];
#pragma unroll
                    for (int bj = 0; bj < 2; ++bj) { const f32x4 v0 = acc[ai][bj][m][0] * rs, v1 = acc[ai][bj][m][1] * rs;
                        float s = (v0[0] * v0[0] + v0[1] * v0[1]) + (v0[2] * v0[2] + v0[3] * v0[3]) + (v1[0] * v1[0] + v1[1] * v1[1]) + (v1[2] * v1[2] + v1[3] * v1[3]);
                        s += __shfl_xor(s, 16); s += __shfl_xor(s, 32);
                        if (fq == 0) X[(rowl * 2 + bj) * 4 + wc] = s; } }
            const int d0 = (hn == 1 ? 32 * (wc & 1) : 32 * wc) + 8 * fq; const f32x4 g0 = *(const f32x4*)(gain + d0), g1 = *(const f32x4*)(gain + d0 + 4);
            asm volatile("s_waitcnt lgkmcnt(0)" ::: "memory"); __builtin_amdgcn_s_barrier(); asm volatile("" ::: "memory");
            const float ihd = hn == 1 ? (1.0f / 64.0f) : (1.0f / 128.0f);
#pragma unroll
            for (int ai = 0; ai < 2; ++ai)
#pragma unroll
                for (int m = 0; m < 4; ++m) { const int rowl = ai * HALF + wr * 64 + m * 16 + fr; bf16_t* rowp = O + (size_t)(row0 + ai * HALF + m * 16) * ldc + col0;
#pragma unroll
                    for (int bj = 0; bj < 2; ++bj) { const f32x4 xs = *(const PG8_LAS f32x4*)(X + (rowl * 2 + bj) * 4);
                        const float tot = hn == 1 ? ((wc & 2) ? xs[2] + xs[3] : xs[0] + xs[1]) : (xs[0] + xs[1]) + (xs[2] + xs[3]);
                        const float r = rsv[ai][m] * hscale / sqrtf(tot * ihd + 1e-6f);
                        const f32x4 v0 = acc[ai][bj][m][0] * r * g0, v1 = acc[ai][bj][m][1] * r * g1;
                        u32x4 w; w.x = cvt_pk_bf16(v0[0], v0[1]); w.y = cvt_pk_bf16(v0[2], v0[3]); w.z = cvt_pk_bf16(v1[0], v1[1]); w.w = cvt_pk_bf16(v1[2], v1[3]);
                        *(u32x4*)(rowp + bj * HALF) = w; } }
            return;
        }
#pragma unroll
        for (int ai = 0; ai < 2; ++ai)
#pragma unroll
            for (int m = 0; m < 4; ++m) { bf16_t* rowp = O + (size_t)(row0 + ai * HALF + m * 16) * ldc + col0; const float rs = rsv[ai][m];
#pragma unroll
                for (int bj = 0; bj < 2; ++bj) { f32x4 v0 = acc[ai][bj][m][0] * rs, v1 = acc[ai][bj][m][1] * rs;
                    if (sg) { v0 = (f32x4){gate_f(v0[0]), gate_f(v0[1]), gate_f(v0[2]), gate_f(v0[3])}; v1 = (f32x4){gate_f(v1[0]), gate_f(v1[1]), gate_f(v1[2]), gate_f(v1[3])}; }
                    u32x4 w; w.x = cvt_pk_bf16(v0[0], v0[1]); w.y = cvt_pk_bf16(v0[2], v0[3]); w.z = cvt_pk_bf16(v1[0], v1[1]); w.w = cvt_pk_bf16(v1[2], v1[3]);
                    *(u32x4*)(rowp + bj * HALF) = w; } }
    }
};
struct EpiGate {
    static constexpr bool PERM = true, AFTER_DRAIN = false, HOOK = true, CTX = false; static constexpr int H1 = 8, H2 = 24;
    bf16_t* MG; const bf16_t* G;
    __device__ __forceinline__ void hook(f32x4 (&acc)[2][2][4][2], const Unit& u, int t, int wr, int wc, int fr, int fq) const {
        asm volatile("" : "+v"(fr), "+v"(fq));
        const int row0 = u.pm * BM + wr * 64 + fr, col0 = u.pn * BM + wc * 32 + 8 * fq, gnum = (t == H1) ? 0 : 2048;
        u32x4 ga[4][2][2], gb[4][2][2];
#define HK_LOAD(c) do { _Pragma("unroll") for (int mm = 0; mm < 2; ++mm) { const bf16_t* gp = G + (size_t)(row0 + ((c) >> 1) * HALF + (((c) & 1) * 2 + mm) * 16) * 6144 + gnum + col0; \
            _Pragma("unroll") for (int bj = 0; bj < 2; ++bj) { ga[c][mm][bj] = *(const u32x4*)(gp + bj * HALF); gb[c][mm][bj] = *(const u32x4*)(gp + 2048 + bj * HALF); } } } while (0)
#define HK_COMP(c) do { _Pragma("unroll") for (int mm = 0; mm < 2; ++mm) _Pragma("unroll") for (int bj = 0; bj < 2; ++bj) { const u32x4 a = ga[c][mm][bj], b = gb[c][mm][bj]; \
            const f32x4 r0 = (f32x4){bf_lo(a.x) * __builtin_amdgcn_rcpf(bf_lo(b.x)), bf_hi(a.x) * __builtin_amdgcn_rcpf(bf_hi(b.x)), bf_lo(a.y) * __builtin_amdgcn_rcpf(bf_lo(b.y)), bf_hi(a.y) * __builtin_amdgcn_rcpf(bf_hi(b.y))}; \
            const f32x4 r1 = (f32x4){bf_lo(a.z) * __builtin_amdgcn_rcpf(bf_lo(b.z)), bf_hi(a.z) * __builtin_amdgcn_rcpf(bf_hi(b.z)), bf_lo(a.w) * __builtin_amdgcn_rcpf(bf_lo(b.w)), bf_hi(a.w) * __builtin_amdgcn_rcpf(bf_hi(b.w))}; \
            acc[(c) >> 1][bj][((c) & 1) * 2 + mm][0] *= r0; acc[(c) >> 1][bj][((c) & 1) * 2 + mm][1] *= r1; } } while (0)
        asm volatile("" ::: "memory");
        HK_LOAD(0); HK_LOAD(1); asm volatile("" ::: "memory");
        HK_COMP(0); HK_LOAD(2); asm volatile("" ::: "memory");
        HK_COMP(1); HK_LOAD(3); asm volatile("" ::: "memory");
        HK_COMP(2); HK_COMP(3);
#undef HK_LOAD
#undef HK_COMP
        asm volatile("s_waitcnt vmcnt(0)" ::: "memory");
    }
    __device__ __forceinline__ void operator()(const f32x4 (&acc)[2][2][4][2], const Unit& u, int wr, int wc, int fr, int fq) const {
        const int row0 = u.pm * BM + wr * 64 + fr, col0 = u.pn * BM + wc * 32 + 8 * fq;
#pragma unroll
        for (int ai = 0; ai < 2; ++ai) {
            u32x4 gq[4][2];
#pragma unroll
            for (int m = 0; m < 4; ++m)
#pragma unroll
                for (int bj = 0; bj < 2; ++bj) gq[m][bj] = *(const u32x4*)(G + (size_t)(row0 + ai * HALF + m * 16) * 6144 + 4096 + col0 + bj * HALF);
#pragma unroll
            for (int m = 0; m < 4; ++m) { const size_t row = (size_t)(row0 + ai * HALF + m * 16);
#pragma unroll
                for (int bj = 0; bj < 2; ++bj) { const int col = col0 + bj * HALF; const u32x4 gv = gq[m][bj];
                    const f32x4 a0 = acc[ai][bj][m][0], a1 = acc[ai][bj][m][1];
                    u32x4 w; w.x = cvt_pk_bf16(bf_lo(gv.x) * a0[0], bf_hi(gv.x) * a0[1]); w.y = cvt_pk_bf16(bf_lo(gv.y) * a0[2], bf_hi(gv.y) * a0[3]);
                    w.z = cvt_pk_bf16(bf_lo(gv.z) * a1[0], bf_hi(gv.z) * a1[1]); w.w = cvt_pk_bf16(bf_lo(gv.w) * a1[2], bf_hi(gv.w) * a1[3]);
                    *(u32x4*)(MG + row * 2048 + col) = w; } } }
    }
};
template <class Epi, class Sched, bool ALIGN_EPI = false, bool SP2 = false>
__device__ __forceinline__ void gemm_phase(PG8_LAS unsigned char* lds, const Gemm g, const Sched& S, const Epi& E) {
    const int tid = threadIdx.x, wid = __builtin_amdgcn_readfirstlane(tid >> 6), lane = tid & 63, wr = wid >> 2, wc = wid & 3, fr = lane & 15, fq = lane >> 4;
    const int K = g.K, nt = K / BK;
    unsigned voffA[2], voffB[2];
#pragma unroll
    for (int i = 0; i < 2; ++i) { int R, C; stage_rc(tid * 16 + i * 8192, R, C); const int Rb = Epi::PERM ? ((R & ~31) + perm32(R & 31)) : R;
        voffA[i] = (unsigned)(R * K + C) * 2u; voffB[i] = (unsigned)(Rb * K + C) * 2u; }
    const size_t kstep = (size_t)(BK * 2);
    const size_t hstep = (size_t)HALF * K * 2;
    const size_t tstep = 2 * hstep;
    const unsigned ldsw = (unsigned)wid * 1024u;
    const int aoff = lds_byte(wr * 64 + fr, fq * 8), boff = lds_byte(wc * 32 + fr, fq * 8);
#define PG8_SA(b, h) (((b) * 2 + (h)) * HTB)
#define PG8_SB(b, h) ((4 + (b) * 2 + (h)) * HTB)
#define PG8_STAGE(bufoff, gbase, voff) do { _Pragma("unroll") for (int _i = 0; _i < 2; ++_i) \
        __builtin_amdgcn_global_load_lds((const unsigned*)((const char*)(gbase) + (voff)[_i]), (PG8_LAS unsigned*)(lds + (bufoff) + ldsw + _i * 8192), 16, 0, 0); } while (0)
#define PG8_LDA(dst, b, h) do { _Pragma("unroll") for (int m = 0; m < 4; ++m) _Pragma("unroll") for (int k = 0; k < 2; ++k) dst[m][k] = *(const PG8_LAS bf16x8*)(lds + PG8_SA(b, h) + aoff + m * 2048 + k * 1024); } while (0)
#define PG8_LDB(dst, b, h) do { _Pragma("unroll") for (int n = 0; n < 2; ++n) _Pragma("unroll") for (int k = 0; k < 2; ++k) dst[n][k] = *(const PG8_LAS bf16x8*)(lds + PG8_SB(b, h) + boff + n * 2048 + k * 1024); } while (0)
#define PG8_MMA(ai, bj, At, Bt) do { __builtin_amdgcn_s_setprio(1); _Pragma("unroll") for (int m = 0; m < 4; ++m) _Pragma("unroll") for (int n = 0; n < 2; ++n) _Pragma("unroll") for (int k = 0; k < 2; ++k) \
        acc[ai][bj][m][n] = __builtin_amdgcn_mfma_f32_16x16x32_bf16(Bt[n][k], At[m][k], acc[ai][bj][m][n], 0, 0, 0); __builtin_amdgcn_s_setprio(0); } while (0)
#define PG8_WAIT_V(n) asm volatile("s_waitcnt vmcnt(" #n ")" ::: "memory")
#define PG8_WAIT_L(n) asm volatile("s_waitcnt lgkmcnt(" #n ")" ::: "memory")
#define PG8_BAR __builtin_amdgcn_s_barrier()
#define PG8_SCHED __builtin_amdgcn_sched_barrier(0)
    Unit cur, nxt; int ui = 0;
    if (!S.next(0, cur)) return;
    f32x4 acc[2][2][4][2];
    float ectx[8] = {1.f, 1.f, 1.f, 1.f, 1.f, 1.f, 1.f, 1.f}; int ectx_pm = -1;
#pragma unroll
    for (int a = 0; a < 2; ++a)
#pragma unroll
        for (int b = 0; b < 2; ++b)
#pragma unroll
            for (int m = 0; m < 4; ++m)
#pragma unroll
                for (int n = 0; n < 2; ++n) acc[a][b][m][n] = (f32x4){0.f, 0.f, 0.f, 0.f};
    bf16x8 At[4][2], B0[2][2], B1[2][2];
    const char* cA = (const char*)g.A + (size_t)cur.pm * tstep; const char* cB = (const char*)g.Bt + (size_t)cur.pn * tstep;
    S.a_ready(cur);
    if constexpr (SP2) {
        PG8_STAGE(PG8_SB(0, 0), cB, voffB); PG8_STAGE(PG8_SB(0, 1), cB + hstep, voffB); PG8_STAGE(PG8_SA(0, 0), cA, voffA); PG8_STAGE(PG8_SA(0, 1), cA + hstep, voffA);
        if (wr == 1) PG8_BAR;
        PG8_WAIT_V(2); PG8_BAR;
        PG8_STAGE(PG8_SB(1, 0), cB + kstep, voffB); PG8_STAGE(PG8_SA(1, 0), cA + kstep, voffA); PG8_STAGE(PG8_SB(1, 1), cB + hstep + kstep, voffB);
        PG8_WAIT_V(6); PG8_BAR;
    } else {
        PG8_STAGE(PG8_SB(0, 0), cB, voffB); PG8_STAGE(PG8_SA(0, 0), cA, voffA); PG8_STAGE(PG8_SB(0, 1), cB + hstep, voffB); PG8_STAGE(PG8_SA(0, 1), cA + hstep, voffA);
        if (wr == 1) PG8_BAR;
        PG8_WAIT_V(4); PG8_BAR;
        PG8_STAGE(PG8_SB(1, 0), cB + kstep, voffB); PG8_STAGE(PG8_SA(1, 0), cA + kstep, voffA); PG8_STAGE(PG8_SB(1, 1), cB + hstep + kstep, voffB);
        PG8_WAIT_V(6); PG8_BAR;
    }
    for (;;) {
        const bool has_next = S.next(ui + 1, nxt);
        const char* nA = has_next ? (const char*)g.A + (size_t)nxt.pm * tstep : cA; const char* nB = has_next ? (const char*)g.Bt + (size_t)nxt.pn * tstep : cB;
        for (int t = 0; t < nt; t += 2) {
            if constexpr (Epi::HOOK) { if (t == Epi::H1 || t == Epi::H2) E.hook(acc, cur, t, wr, wc, fr, fq); }
            const bool last = (t == nt - 2);
            const char* a1 = cA + (size_t)(t + 1) * kstep;
            const char* a2 = last ? nA : cA + (size_t)(t + 2) * kstep; const char* b2 = last ? nB : cB + (size_t)(t + 2) * kstep;
            const char* a3 = a2 + kstep; const char* b3 = b2 + kstep;
            if (last && has_next) S.a_ready(nxt);
            if constexpr (SP2) {
            PG8_LDB(B0, 0, 0); PG8_LDB(B1, 0, 1); PG8_SCHED; PG8_LDA(At, 0, 0); PG8_STAGE(PG8_SA(1, 1), a1 + hstep, voffA);
            PG8_WAIT_V(8); PG8_WAIT_L(0); PG8_BAR; PG8_MMA(0, 0, At, B0); PG8_MMA(0, 1, At, B1); PG8_BAR; PG8_SCHED;
            PG8_LDA(At, 0, 1); PG8_STAGE(PG8_SB(0, 0), b2, voffB); PG8_STAGE(PG8_SB(0, 1), b2 + hstep, voffB); PG8_STAGE(PG8_SA(0, 0), a2, voffA);
            PG8_WAIT_V(8); PG8_WAIT_L(0); PG8_BAR; PG8_MMA(1, 0, At, B0); PG8_MMA(1, 1, At, B1); PG8_BAR; PG8_SCHED;
            PG8_LDB(B0, 1, 0); PG8_LDB(B1, 1, 1); PG8_SCHED; PG8_LDA(At, 1, 0); PG8_STAGE(PG8_SA(0, 1), a2 + hstep, voffA);
            PG8_WAIT_V(8); PG8_WAIT_L(0); PG8_BAR; PG8_MMA(0, 0, At, B0); PG8_MMA(0, 1, At, B1); PG8_BAR; PG8_SCHED;
            PG8_LDA(At, 1, 1); PG8_STAGE(PG8_SB(1, 0), b3, voffB); PG8_STAGE(PG8_SB(1, 1), b3 + hstep, voffB); PG8_STAGE(PG8_SA(1, 0), a3, voffA);
            PG8_WAIT_V(8); PG8_WAIT_L(0); PG8_BAR; PG8_MMA(1, 0, At, B0); PG8_MMA(1, 1, At, B1); PG8_BAR; PG8_SCHED;
            } else {
            PG8_LDB(B0, 0, 0); PG8_SCHED; PG8_LDA(At, 0, 0); PG8_STAGE(PG8_SA(1, 1), a1 + hstep, voffA);
            PG8_WAIT_L(8); PG8_BAR; PG8_WAIT_L(0); PG8_MMA(0, 0, At, B0); PG8_BAR; PG8_SCHED;
            PG8_LDB(B1, 0, 1); PG8_STAGE(PG8_SB(0, 0), b2, voffB);
            PG8_BAR; PG8_WAIT_L(0); PG8_MMA(0, 1, At, B1); PG8_BAR;
            PG8_LDA(At, 0, 1); PG8_STAGE(PG8_SA(0, 0), a2, voffA);
            PG8_BAR; PG8_WAIT_L(0); PG8_MMA(1, 0, At, B0); PG8_BAR; PG8_SCHED;
            PG8_STAGE(PG8_SB(0, 1), b2 + hstep, voffB);
            PG8_WAIT_V(6); PG8_BAR; PG8_MMA(1, 1, At, B1); PG8_BAR;
            PG8_LDB(B0, 1, 0); PG8_SCHED; PG8_LDA(At, 1, 0); PG8_STAGE(PG8_SA(0, 1), a2 + hstep, voffA);
            PG8_WAIT_L(8); PG8_BAR; PG8_WAIT_L(0); PG8_MMA(0, 0, At, B0); PG8_BAR; PG8_SCHED;
            PG8_LDB(B1, 1, 1); PG8_STAGE(PG8_SB(1, 0), b3, voffB);
            PG8_BAR; PG8_WAIT_L(0); PG8_MMA(0, 1, At, B1); PG8_BAR;
            PG8_LDA(At, 1, 1); PG8_STAGE(PG8_SA(1, 0), a3, voffA);
            PG8_BAR; PG8_WAIT_L(0); PG8_MMA(1, 0, At, B0); PG8_BAR; PG8_SCHED;
            PG8_STAGE(PG8_SB(1, 1), b3 + hstep, voffB);
            PG8_WAIT_V(6); PG8_BAR; PG8_MMA(1, 1, At, B1); PG8_BAR;
            }
        }
        if constexpr (ALIGN_EPI) { if (wr == 0) PG8_BAR; }
        if constexpr (!Epi::AFTER_DRAIN) { if constexpr (Epi::CTX) E.run(acc, cur, wr, wc, fr, fq, ectx, ectx_pm); else E(acc, cur, wr, wc, fr, fq); S.done(cur); }
        if (!has_next) break;
#pragma unroll
        for (int a = 0; a < 2; ++a)
#pragma unroll
            for (int b = 0; b < 2; ++b)
#pragma unroll
                for (int m = 0; m < 4; ++m)
#pragma unroll
                    for (int n = 0; n < 2; ++n) acc[a][b][m][n] = (f32x4){0.f, 0.f, 0.f, 0.f};
        cur = nxt; cA = nA; cB = nB; ++ui;
        if constexpr (ALIGN_EPI) { if (wr == 1) PG8_BAR; }
    }
    PG8_WAIT_V(0);
    if constexpr (!ALIGN_EPI) { if (wr == 0) PG8_BAR; }
    PG8_BAR;
    if constexpr (Epi::AFTER_DRAIN) { E.fused(acc, cur, wr, wc, fr, fq, lds, wid, lane); S.done(cur); }
#undef PG8_SA
#undef PG8_SB
#undef PG8_STAGE
#undef PG8_LDA
#undef PG8_LDB
#undef PG8_MMA
#undef PG8_WAIT_V
#undef PG8_WAIT_L
#undef PG8_BAR
#undef PG8_SCHED
}
}
#include <hip/hip_bf16.h>
#include <cmath>
namespace attn_body {
using bf16=__hip_bfloat16;
using bf16x8=__attribute__((ext_vector_type(8)))short;
using s16x4=__attribute__((ext_vector_type(4)))short;
using f32x16=__attribute__((ext_vector_type(16)))float;
using u32x4=__attribute__((ext_vector_type(4)))unsigned;
constexpr int BATCH=16,NHEAD=16,SEQ=2048,D=64,DM=NHEAD*D;
constexpr int NW=8,QBLK=32,QB=QBLK*NW,KVBLK=64,NQB=SEQ/QB;
constexpr int ATTN_PITCH=DM, ATTN_UNIT_ROWS=QB, OPITCH=2048;
__device__ __forceinline__ int crow(int r,int hi){return (r&3)+8*(r>>2)+4*hi;}
#define SBAR() __builtin_amdgcn_sched_barrier(0)
__device__ __forceinline__ void cmask(f32x16&p0,f32x16&p1,int jb,int qrel,int hi){
  const float NEG=-INFINITY; int kb=64*jb+4*hi;
  #pragma unroll
  for(int r=0;r<16;++r){int kv=kb+(r&3)+8*(r>>2); if(kv>qrel)p0[r]=NEG; if(kv+32>qrel)p1[r]=NEG;}
}

constexpr int NSLOT=3, SLOTB=8192;
constexpr int LDS_K=0, LDS_V=NSLOT*SLOTB, LDS_WS=2*NSLOT*SLOTB, LDS_OST=LDS_WS+NW*64*4, LDS_KB=LDS_OST+NW*4096, LDS_BYTES=LDS_KB+SEQ*4;
constexpr float C2=0.125f*1.4426950408889634f;
__device__ __forceinline__ void glds16(const void*gsrc,unsigned lds_dst){unsigned keep;
  asm volatile("s_mov_b32 %0, m0\n\ts_mov_b32 m0, %2\n\ts_nop 0\n\tglobal_load_lds_dwordx4 %1, off\n\ts_mov_b32 m0, %0":"=&s"(keep):"v"(gsrc),"s"(lds_dst):"memory");}
__device__ __forceinline__ float max3f(float a,float b,float c){float r;asm("v_max3_f32 %0, %1, %2, %3":"=v"(r):"v"(a),"v"(b),"v"(c));return r;}
__device__ __forceinline__ float max2f(float a,float b){float r;asm("v_max_f32_e32 %0, %1, %2":"=v"(r):"v"(a),"v"(b));return r;}
__device__ __forceinline__ float fadd_s(float a,float b){float r;asm("v_add_f32_e32 %0, %1, %2":"=v"(r):"v"(a),"v"(b));return r;}
__device__ __forceinline__ float fsub_s(float a,float b){float r;asm("v_sub_f32_e32 %0, %1, %2":"=v"(r):"v"(a),"v"(b));return r;}
typedef float f32x2_t __attribute__((ext_vector_type(2))); typedef __bf16 bf16x2_t __attribute__((ext_vector_type(2)));
__device__ __forceinline__ unsigned cvtpk_s(float lo,float hi){f32x2_t v={lo,hi};bf16x2_t b=__builtin_convertvector(v,bf16x2_t);return __builtin_bit_cast(unsigned,b);}
#define WAIT_BAR(N) asm volatile("s_waitcnt vmcnt(" #N ") lgkmcnt(0)\n\ts_barrier":::"memory")

__device__ __forceinline__ void qkt(f32x16&p0,f32x16&p1,const char*Kslot,const bf16x8*qr,int r32,int hi){
  const char*kb=Kslot+hi*1024+r32*16;
  #pragma unroll
  for(int d0=0;d0<4;++d0){
    const bf16x8 b0=*reinterpret_cast<const bf16x8*>(kb+d0*2048);
    const bf16x8 b1=*reinterpret_cast<const bf16x8*>(kb+d0*2048+512);
    {p0=__builtin_amdgcn_mfma_f32_32x32x16_bf16(b0,qr[d0],p0,0,0,0);p1=__builtin_amdgcn_mfma_f32_32x32x16_bf16(b1,qr[d0],p1,0,0,0);}}
}
typedef __attribute__((address_space(3))) const char* lds_cptr;
typedef short v4i16_t __attribute__((ext_vector_type(4)));
__device__ __forceinline__ void kload8(bf16x8*kf,lds_cptr kp){
  kf[0]=*(const __attribute__((address_space(3))) bf16x8*)(kp);      kf[1]=*(const __attribute__((address_space(3))) bf16x8*)(kp+512);
  kf[2]=*(const __attribute__((address_space(3))) bf16x8*)(kp+2048); kf[3]=*(const __attribute__((address_space(3))) bf16x8*)(kp+2560);
  kf[4]=*(const __attribute__((address_space(3))) bf16x8*)(kp+4096); kf[5]=*(const __attribute__((address_space(3))) bf16x8*)(kp+4608);
  kf[6]=*(const __attribute__((address_space(3))) bf16x8*)(kp+6144); kf[7]=*(const __attribute__((address_space(3))) bf16x8*)(kp+6656);
}
__device__ __forceinline__ void kload2(bf16x8*kf,lds_cptr kp,int j){ kf[2*j]=*(const __attribute__((address_space(3))) bf16x8*)(kp+j*2048); kf[2*j+1]=*(const __attribute__((address_space(3))) bf16x8*)(kp+j*2048+512); }
__device__ __forceinline__ s16x4 vtr(lds_cptr p){ return __builtin_bit_cast(s16x4,__builtin_amdgcn_ds_read_tr16_b64_v4i16((__attribute__((address_space(3))) v4i16_t*)p)); }
__device__ __forceinline__ float rowmax(const f32x16&p0,const f32x16&p1){
  float a=max3f(p0[0],p0[1],p1[0]),b=max3f(p0[2],p0[3],p1[1]);a=max3f(a,p1[2],p1[3]);
  #pragma unroll
  for(int r=4;r<16;r+=4){a=max3f(a,p0[r],p0[r+1]);b=max3f(b,p0[r+2],p0[r+3]);a=max3f(a,p1[r],p1[r+1]);b=max3f(b,p1[r+2],p1[r+3]);}
  const float m=max2f(a,b);
  auto rr=__builtin_amdgcn_permlane32_swap(__float_as_uint(m),__float_as_uint(m),false,false);
  return max2f(__uint_as_float(rr[0]),__uint_as_float(rr[1]));
}
__device__ __forceinline__ void pv(f32x16*o,int vb,bf16x8 pa0,bf16x8 pa1,bf16x8 pa2,bf16x8 pa3){
  #pragma unroll
  for(int d0=0;d0<2;++d0){s16x4 lo[4],hi[4];
    #pragma unroll
    for(int ks=0;ks<4;++ks){
      asm volatile("ds_read_b64_tr_b16 %0,%1 offset:%c2":"=&v"(lo[ks]):"v"(vb),"i"(d0*4096+ks*1024):"memory");
      asm volatile("ds_read_b64_tr_b16 %0,%1 offset:%c2":"=&v"(hi[ks]):"v"(vb),"i"(d0*4096+ks*1024+512):"memory");}
    asm volatile("s_waitcnt lgkmcnt(0)":::"memory");SBAR();
    #define PK(k) (bf16x8){lo[k][0],lo[k][1],lo[k][2],lo[k][3],hi[k][0],hi[k][1],hi[k][2],hi[k][3]}
    o[d0]=__builtin_amdgcn_mfma_f32_32x32x16_bf16(pa0,PK(0),o[d0],0,0,0);
    o[d0]=__builtin_amdgcn_mfma_f32_32x32x16_bf16(pa1,PK(1),o[d0],0,0,0);
    o[d0]=__builtin_amdgcn_mfma_f32_32x32x16_bf16(pa2,PK(2),o[d0],0,0,0);
    o[d0]=__builtin_amdgcn_mfma_f32_32x32x16_bf16(pa3,PK(3),o[d0],0,0,0);
    #undef PK
  }
}

#ifndef ATTN_STORE16
#define ATTN_STORE16(p,v) (*(u32x4*)(p)=(v))
#endif
template<int THRL> __device__ __forceinline__ void attn_unit(int b,int h,int qb,const bf16*Q,const bf16*__restrict__ K,const bf16*__restrict__ V,bf16*O,const float*__restrict__ CL,char*shm,bool pre,bool nxt){
  const int tid=threadIdx.x,lane=tid&63,r32=lane&31,hi=lane>>5; const int wid=__builtin_amdgcn_readfirstlane(tid>>6);
  const long rowbase=(long)b*SEQ; const int q0=qb*QB;
  const bf16*Qw=Q+(rowbase+q0+wid*QBLK)*DM+h*D;
  const bf16*Kh=K+rowbase*DM+h*D,*Vh=V+rowbase*DM+h*D;
  const unsigned lds0=(unsigned)(uintptr_t)shm;
  float*wsf=(float*)(shm+LDS_WS)+wid*64;
  typedef __attribute__((address_space(3))) float lds_f32; typedef float f32x4_t __attribute__((ext_vector_type(4)));
  lds_f32*kbl3=(lds_f32*)((__attribute__((address_space(3))) char*)shm+LDS_KB);
  const float clq=-kbl3[qb*QB+wid*QBLK+(lane&31)];
  const bf16*ksrc=Kh+(long)lane*DM+wid*8;
  const bf16*vsrc=Vh+(long)(16*(wid&3)+(lane>>2))*DM+(wid>>2)*32+(lane&3)*8;
  const unsigned kdst=lds0+LDS_K+wid*1024, vdst=lds0+LDS_V+wid*1024;
  #define DMA_K(t,slot) glds16(ksrc+(long)(t)*KVBLK*DM,(unsigned)__builtin_amdgcn_readfirstlane(kdst+(slot)))
  #define DMA_V(t,slot) glds16(vsrc+(long)(t)*KVBLK*DM,(unsigned)__builtin_amdgcn_readfirstlane(vdst+(slot)))
  const int vb0=(int)(lds0+LDS_V)+((lane>>4)&1)*32+(lane&3)*8+(4*hi+((lane&15)>>2))*64;
  const char*Kbase=shm+LDS_K; bf16x8 kf[8];
  const lds_cptr shm3=(lds_cptr)shm; const lds_cptr kp0=shm3+LDS_K+hi*1024+r32*16; const lds_cptr vp0=shm3+LDS_V+((lane>>4)&1)*32+(lane&3)*8+(4*hi+((lane&15)>>2))*64;
  const int NT=(q0+QB)/KVBLK;
  if(!pre){DMA_K(0,0);DMA_V(0,0);DMA_K(1,SLOTB);}
  bf16x8 qr[4];
  #pragma unroll
  for(int d0=0;d0<4;++d0)qr[d0]=*reinterpret_cast<const bf16x8*>(&Qw[(long)r32*DM+d0*16+hi*8]);
  float mhat=-clq,l_reg=0.f;f32x16 o[2];o[0]=f32x16{};o[1]=f32x16{};
  #define KINIT(X0,X1,t) do{ const __attribute__((address_space(3))) f32x4_t* kb_=(const __attribute__((address_space(3))) f32x4_t*)(kbl3+(t)*KVBLK+4*hi); \
    _Pragma("unroll") for(int g_=0;g_<4;++g_){ const f32x4_t ka_=kb_[2*g_], kc_=kb_[2*g_+8]; \
      X0[4*g_]=ka_[0]-mhat;X0[4*g_+1]=ka_[1]-mhat;X0[4*g_+2]=ka_[2]-mhat;X0[4*g_+3]=ka_[3]-mhat; X1[4*g_]=kc_[0]-mhat;X1[4*g_+1]=kc_[1]-mhat;X1[4*g_+2]=kc_[2]-mhat;X1[4*g_+3]=kc_[3]-mhat; } }while(0)
  #define KLOAD(X0,X1,t) do{ const __attribute__((address_space(3))) f32x4_t* kb_=(const __attribute__((address_space(3))) f32x4_t*)(kbl3+(t)*KVBLK+4*hi); \
    _Pragma("unroll") for(int g_=0;g_<4;++g_){ const f32x4_t ka_=kb_[2*g_], kc_=kb_[2*g_+8]; \
      X0[4*g_]=ka_[0];X0[4*g_+1]=ka_[1];X0[4*g_+2]=ka_[2];X0[4*g_+3]=ka_[3]; X1[4*g_]=kc_[0];X1[4*g_+1]=kc_[1];X1[4*g_+2]=kc_[2];X1[4*g_+3]=kc_[3]; } }while(0)
  #define KSUB(X0,X1) do{ _Pragma("unroll") for(int r_=0;r_<16;++r_){ X0[r_]-=mhat; X1[r_]-=mhat; } }while(0)
  const int qrel=wid*QBLK+r32;
  #define CMASK(P0,P1,t) do{int jb_=(t)-(NT-4); if(jb_>=0)cmask(P0,P1,jb_,qrel,hi);}while(0)
  bool resc=false;
  #define START(P0,P1) do{ const float rm=rowmax(P0,P1); resc=false; \
    { const float dl=rm; mhat=fadd_s(mhat,dl); \
      _Pragma("unroll") for(int r=0;r<16;++r){P0[r]=fsub_s(P0[r],dl);P1[r]=fsub_s(P1[r],dl);} \
      } \
    _Pragma("unroll") for(int r=0;r<16;++r)P0[r]=__builtin_amdgcn_exp2f(P0[r]); }while(0)
  #define RESC() do{ if(resc){ asm volatile("s_waitcnt lgkmcnt(0)":::"memory"); \
      _Pragma("unroll") for(int d_=0;d_<2;++d_) _Pragma("unroll") for(int r=0;r<16;++r)o[d_][r]*=wsf[crow(r,hi)]; } }while(0)
  f32x16 pA0,pA1,pB0,pB1;
  int sl_prev=0,sl_cur=0,sl_next=SLOTB;
  #define ROT() do{sl_prev=sl_cur;sl_cur=sl_next;sl_next=(sl_next==(NSLOT-1)*SLOTB)?0:sl_next+SLOTB;}while(0)
  if(!pre){DMA_K(2,2*SLOTB);}
  WAIT_BAR(3);
  KINIT(pA0,pA1,0);qkt(pA0,pA1,Kbase,qr,r32,hi);asm volatile("s_nop 15\n\ts_nop 7":"+v"(pA0),"+v"(pA1));CMASK(pA0,pA1,0);
  START(pA0,pA1);
  _Pragma("unroll") for(int r=0;r<16;++r)pA1[r]=__builtin_amdgcn_exp2f(pA1[r]);
  KINIT(pB0,pB1,1);
  WAIT_BAR(0);
  DMA_K(3,0);DMA_V(1,SLOTB);
  ROT();
  kload8(kf,kp0+sl_cur);
  WAIT_BAR(2);
  s16x4 vlo[8],vhi[8]; u32x4 pw0,pw1,pw2,pw3;
  #define PKW(P,B) cvtpk_s(P[B],P[B+1])
  #define PAF(k) __builtin_bit_cast(bf16x8,pw##k)
  #define VFR(i) (bf16x8){vlo[i][0],vlo[i][1],vlo[i][2],vlo[i][3],vhi[i][0],vhi[i][1],vhi[i][2],vhi[i][3]}
  #define PIN(x) asm volatile("":"+v"(x))
  #define MX3(a,b,c) __builtin_fmaxf(__builtin_fmaxf((a),(b)),(c))
  #define GAPA(MF,A0,A1,A2,A3,W0,W1,PW) do{ MF; sacc+=A0; sacc+=A1; sacc+=A2; sacc+=A3; PIN(sacc); W0; W1; PIN(PW); SBAR(); }while(0)
  #define EX(v) __builtin_amdgcn_exp2f(v)
  #define GAPB(MF,X,B) do{ MF; X[B]=EX(X[B]); X[B+1]=EX(X[B+1]); X[B+2]=EX(X[B+2]); X[B+3]=EX(X[B+3]); PIN(X); SBAR(); }while(0)
  #define VRD(i) do{ vlo[i]=vtr(vp_+(((i)>>2)*4096+((i)&3)*1024)); vhi[i]=vtr(vp_+(((i)>>2)*4096+((i)&3)*1024+512)); }while(0)
  #define KRD(G,j) do{ if(G){ kload2(kf,kp0+sl_next,j); SBAR(); } }while(0)
  #define STEP(C0,C1,P0,P1,t,GK,GV,GL) do{ SBAR(); \
    const lds_cptr vp_=vp0+sl_prev; \
    VRD(0); SBAR(); float sacc=(P0[0]+P0[1]); \
    GAPA(C0=__builtin_amdgcn_mfma_f32_32x32x16_bf16(kf[0],qr[0],C0,0,0,0), P0[2],P0[3],P0[4],P0[5],     pw0[0]=PKW(P0,0), pw0[1]=PKW(P0,2), pw0); \
    VRD(4); SBAR(); GAPA(C1=__builtin_amdgcn_mfma_f32_32x32x16_bf16(kf[1],qr[0],C1,0,0,0), P0[6],P0[7],P0[8],P0[9],     pw0[2]=PKW(P0,4), pw0[3]=PKW(P0,6), pw0); \
    VRD(1); SBAR(); GAPA(C0=__builtin_amdgcn_mfma_f32_32x32x16_bf16(kf[2],qr[1],C0,0,0,0),   P0[10],P0[11],P0[12],P0[13], pw1[0]=PKW(P0,8), pw1[1]=PKW(P0,10), pw1); \
    VRD(5); SBAR(); GAPA(C1=__builtin_amdgcn_mfma_f32_32x32x16_bf16(kf[3],qr[1],C1,0,0,0),   P0[14],P0[15],P1[0],P1[1],   pw1[2]=PKW(P0,12),pw1[3]=PKW(P0,14), pw1); \
    VRD(2); SBAR(); GAPA(C0=__builtin_amdgcn_mfma_f32_32x32x16_bf16(kf[4],qr[2],C0,0,0,0),   P1[2],P1[3],P1[4],P1[5],     pw2[0]=PKW(P1,0), pw2[1]=PKW(P1,2), pw2); \
    VRD(6); SBAR(); GAPA(C1=__builtin_amdgcn_mfma_f32_32x32x16_bf16(kf[5],qr[2],C1,0,0,0),   P1[6],P1[7],P1[8],P1[9],     pw2[2]=PKW(P1,4), pw2[3]=PKW(P1,6), pw2); \
    VRD(3); SBAR(); GAPA(C0=__builtin_amdgcn_mfma_f32_32x32x16_bf16(kf[6],qr[3],C0,0,0,0),   P1[10],P1[11],P1[12],P1[13], pw3[0]=PKW(P1,8), pw3[1]=PKW(P1,10), pw3); \
    VRD(7); SBAR(); GAPA(C1=__builtin_amdgcn_mfma_f32_32x32x16_bf16(kf[7],qr[3],C1,0,0,0),   P1[14],P1[15],0.f,0.f,       pw3[2]=PKW(P1,12),pw3[3]=PKW(P1,14), pw3); \
    l_reg+=sacc; \
    if(GK){DMA_K((t)+3,sl_cur);} if(GV){DMA_V((t)+1,sl_next);} \
    CMASK(C0,C1,t); \
    { float a=MX3(C0[0],C0[1],C1[0]),b=MX3(C0[2],C0[3],C1[1]); a=MX3(a,C1[2],C1[3]); \
      _Pragma("unroll") for(int r=4;r<16;r+=4){a=MX3(a,C0[r],C0[r+1]);b=MX3(b,C0[r+2],C0[r+3]);a=MX3(a,C1[r],C1[r+1]);b=MX3(b,C1[r+2],C1[r+3]);} \
      float rm=__builtin_fmaxf(a,b); { auto rr=__builtin_amdgcn_permlane32_swap(__float_as_uint(rm),__float_as_uint(rm),false,false); rm=__builtin_fmaxf(__uint_as_float(rr[0]),__uint_as_float(rr[1])); } \
      resc=false; \
      if(__builtin_expect(__any(rm>(float)THRL),0)){ const float dl=__builtin_fmaxf(rm,0.f); mhat+=dl; \
        _Pragma("unroll") for(int r=0;r<16;++r){C0[r]-=dl;C1[r]-=dl;} \
        const float f=__builtin_amdgcn_exp2f(-dl); l_reg*=f; if(hi==0)wsf[r32]=f; resc=true; } } \
    SBAR(); \
    if(GV){ KLOAD(P0,P1,(t)+1); } SBAR(); \
    GAPB(o[0]=__builtin_amdgcn_mfma_f32_32x32x16_bf16(PAF(0),VFR(0),o[0],0,0,0), C0,0); \
    GAPB(o[1]=__builtin_amdgcn_mfma_f32_32x32x16_bf16(PAF(0),VFR(4),o[1],0,0,0), C0,4); \
    KRD(GL,0); GAPB(o[0]=__builtin_amdgcn_mfma_f32_32x32x16_bf16(PAF(1),VFR(1),o[0],0,0,0), C0,8); \
    KRD(GL,1); GAPB(o[1]=__builtin_amdgcn_mfma_f32_32x32x16_bf16(PAF(1),VFR(5),o[1],0,0,0), C0,12); \
    KRD(GL,2); GAPB(o[0]=__builtin_amdgcn_mfma_f32_32x32x16_bf16(PAF(2),VFR(2),o[0],0,0,0), C1,0); \
    KRD(GL,3); GAPB(o[1]=__builtin_amdgcn_mfma_f32_32x32x16_bf16(PAF(2),VFR(6),o[1],0,0,0), C1,4); \
    GAPB(o[0]=__builtin_amdgcn_mfma_f32_32x32x16_bf16(PAF(3),VFR(3),o[0],0,0,0), C1,8); \
    GAPB(o[1]=__builtin_amdgcn_mfma_f32_32x32x16_bf16(PAF(3),VFR(7),o[1],0,0,0), C1,12); \
    if(GV){ KSUB(P0,P1); } \
    }while(0)
  int t=1;
  #undef CMASK
  #define CMASK(P0,P1,t) do{}while(0)
  for(;t+5<NT;t+=2){
    STEP(pB0,pB1,pA0,pA1,t,true,true,true);     WAIT_BAR(2); RESC(); ROT();
    STEP(pA0,pA1,pB0,pB1,t+1,true,true,true);   WAIT_BAR(2); RESC(); ROT();
  }
  #undef CMASK
  #define CMASK(P0,P1,t) do{int jb_=(t)-(NT-4); if(jb_>=0)cmask(P0,P1,jb_,qrel,hi);}while(0)
  #define ENDW(tt) do{ if((tt)+3<NT){WAIT_BAR(2);} else if((tt)+2<NT){WAIT_BAR(1);} else {WAIT_BAR(0);} }while(0)
  for(;t+1<NT;t+=2){
    STEP(pB0,pB1,pA0,pA1,t,(t+3<NT),(t+1<NT),(t+1<NT));       ENDW(t);   RESC(); ROT();
    STEP(pA0,pA1,pB0,pB1,t+1,(t+4<NT),(t+2<NT),(t+2<NT));     ENDW(t+1); RESC(); ROT();
  }
  STEP(pB0,pB1,pA0,pA1,NT-1,false,false,false); RESC();
  { float sacc=pB0[0]+pB0[1]; _Pragma("unroll") for(int r=2;r<16;++r)sacc+=pB0[r]; _Pragma("unroll") for(int r=0;r<16;++r)sacc+=pB1[r]; l_reg+=sacc;
    pw0=(u32x4){PKW(pB0,0),PKW(pB0,2),PKW(pB0,4),PKW(pB0,6)};pw1=(u32x4){PKW(pB0,8),PKW(pB0,10),PKW(pB0,12),PKW(pB0,14)};pw2=(u32x4){PKW(pB1,0),PKW(pB1,2),PKW(pB1,4),PKW(pB1,6)};pw3=(u32x4){PKW(pB1,8),PKW(pB1,10),PKW(pB1,12),PKW(pB1,14)};
    SBAR(); pv(o,vb0+sl_cur,PAF(0),PAF(1),PAF(2),PAF(3)); }
  if(nxt){ asm volatile("s_waitcnt lgkmcnt(0)\n\ts_barrier":::"memory"); DMA_K(0,0);DMA_V(0,0);DMA_K(1,SLOTB);DMA_K(2,2*SLOTB); }
  #undef PKW
  #undef PAF
  #undef VFR
  #undef PIN
  #undef MX3
  #undef GAPA
  #undef GAPB
  #undef EX
  #undef VRD
  #undef KRD
  #undef STEP
  #undef ENDW
  {auto rr=__builtin_amdgcn_permlane32_swap(__float_as_uint(l_reg),__float_as_uint(l_reg),false,false);l_reg=__uint_as_float(rr[0])+__uint_as_float(rr[1]);}
  if(hi==0)wsf[32+r32]=l_reg;asm volatile("s_waitcnt lgkmcnt(0)":::"memory");
  float rli[16];
  #pragma unroll
  for(int r=0;r<16;++r)rli[r]=__builtin_amdgcn_rcpf(wsf[32+crow(r,hi)]);
  bf16*Ow=O+(rowbase+q0+wid*QBLK)*OPITCH+h*D;
  { bf16*stg=(bf16*)(shm+LDS_OST)+wid*2048;
    #pragma unroll
    for(int r=0;r<16;++r){const int orow=crow(r,hi);
      #pragma unroll
      for(int d0=0;d0<2;++d0)stg[orow*64+d0*32+r32]=__float2bfloat16(o[d0][r]*rli[r]);}
    asm volatile("s_waitcnt lgkmcnt(0)":::"memory");
    #pragma unroll
    for(int i=0;i<4;++i){const int row=i*8+(lane>>3),ch=lane&7; const u32x4 v=*(const u32x4*)(stg+row*64+ch*8); ATTN_STORE16(Ow+(long)row*OPITCH+ch*8,v);} }
  asm volatile("s_waitcnt lgkmcnt(0)\n\ts_barrier":::"memory");
  #undef KINIT
  #undef KLOAD
  #undef KSUB
  #undef DMA_K
  #undef DMA_V
  #undef CMASK
  #undef START
  #undef RESC
  #undef ROT
}
constexpr int ATTN_LDS_BYTES=LDS_BYTES;
struct AttnTensors { const bf16* Q; const bf16* K; const bf16* V; bf16* O; const float* CL; };
struct AttnUnit { int bh; int qb; };
struct StaticOrder {
  int vcu, G;
  __device__ __forceinline__ explicit StaticOrder(int grid,int v):vcu(v),G(grid){}
  __device__ __forceinline__ bool next(int i,AttnUnit&u)const{ const int bh=vcu+(i/NQB)*G; if(bh>=BATCH*NHEAD)return false; u.bh=bh; u.qb=NQB-1-(i%NQB); return true; }
  __device__ __forceinline__ void a_ready(const AttnUnit&)const{}
  __device__ __forceinline__ void done(const AttnUnit&)const{}
};
__device__ __forceinline__ void build_bias(int b,int h,const float*__restrict__ LOGF,char*shm){
  typedef __attribute__((address_space(3))) float lds_f32; typedef float f32x4_t __attribute__((ext_vector_type(4)));
  const int tid=threadIdx.x,lane=tid&63; const int wid=__builtin_amdgcn_readfirstlane(tid>>6);
  lds_f32*kbl3=(lds_f32*)((__attribute__((address_space(3))) char*)shm+LDS_KB); lds_f32*wtot=(lds_f32*)((__attribute__((address_space(3))) char*)shm+LDS_WS);
  const float*src=LOGF+((long)b*SEQ+4*tid)*NHEAD+h;
  float a0=src[0],a1=src[NHEAD],a2=src[2*NHEAD],a3=src[3*NHEAD]; a1+=a0;a2+=a1;a3+=a2;
  float inc=a3;
  #pragma unroll
  for(int o=1;o<64;o<<=1){ const float t=__shfl_up(inc,o); if(lane>=o)inc+=t; }
  if(lane==63)wtot[wid]=inc;
  asm volatile("s_waitcnt lgkmcnt(0)\n\ts_barrier":::"memory");
  float base=0.f;
  #pragma unroll
  for(int w=0;w<NW;++w){ const float t=wtot[w]; if(w<wid)base+=t; }
  const float ex=base+inc-a3; const float c=-1.4426950408889634f;
  *(__attribute__((address_space(3))) f32x4_t*)(kbl3+4*tid)=(f32x4_t){(ex+a0)*c,(ex+a1)*c,(ex+a2)*c,(ex+a3)*c};
  asm volatile("s_waitcnt lgkmcnt(0)\n\ts_barrier":::"memory");
}
template<class Sched,int THRL=8> __device__ __forceinline__ void attn_phase(char*lds,const AttnTensors&T,const Sched&S){
  AttnUnit u,un; int cur_bh=-1; bool have=S.next(0,u);
  for(int i=0;have;++i){ const bool fresh=(u.bh!=cur_bh); if(fresh){ build_bias(u.bh/NHEAD,u.bh%NHEAD,T.CL,lds); cur_bh=u.bh; }
    const bool hn=S.next(i+1,un); const bool nxt=hn&&(un.bh==u.bh);
    S.a_ready(u); attn_unit<THRL>(u.bh/NHEAD,u.bh%NHEAD,u.qb,T.Q,T.K,T.V,T.O,T.CL,lds,!fresh,nxt); S.done(u);
    u=un; have=hn; }
}
#undef SBAR
#undef WAIT_BAR
}
namespace memattn {
using attn_body::bf16x8; using attn_body::f32x16; using attn_body::s16x4; using attn_body::u32x4;
#define MLAS __attribute__((address_space(3)))
constexpr int KSTR = 272, VSTR = 520, K_OFF = 0, V_OFF = 256 * KSTR, WSF_OFF = V_OFF + 128 * VSTR, MEM_LDS_BYTES = WSF_OFF + 8 * 256;
__device__ __forceinline__ void stage_kv(int b, int hm, const unsigned short* KM, const unsigned short* VT, const float* kgain, MLAS unsigned char* L) {
    int tid = threadIdx.x; asm volatile("" : "+v"(tid));
    { const int c = tid & 15, r0 = tid >> 4;
      const unsigned short* src = KM + ((long)b * 256 + r0) * 512 + hm * 128 + c * 8;
      float g[8];
#pragma unroll
      for (int j = 0; j < 8; ++j) g[j] = kgain[c * 8 + j];
      u32x4 vv[8];
#pragma unroll
      for (int p = 0; p < 8; ++p) vv[p] = *reinterpret_cast<const u32x4*>(src + (long)p * 32 * 512);
#pragma unroll
      for (int p = 0; p < 8; ++p) { const u32x4 v = vv[p];
          float f[8] = {__uint_as_float(v.x << 16), __uint_as_float(v.x & 0xffff0000u), __uint_as_float(v.y << 16), __uint_as_float(v.y & 0xffff0000u), __uint_as_float(v.z << 16), __uint_as_float(v.z & 0xffff0000u), __uint_as_float(v.w << 16), __uint_as_float(v.w & 0xffff0000u)};
          float ss = 0.f;
#pragma unroll
          for (int j = 0; j < 8; ++j) ss += f[j] * f[j];
          ss += __shfl_xor(ss, 1); ss += __shfl_xor(ss, 2); ss += __shfl_xor(ss, 4); ss += __shfl_xor(ss, 8);
          const float r = 1.0f / sqrtf(ss * (1.0f / 128.0f) + 1e-6f);
          u32x4 o; o.x = attn_body::cvtpk_s(f[0] * r * g[0], f[1] * r * g[1]); o.y = attn_body::cvtpk_s(f[2] * r * g[2], f[3] * r * g[3]); o.z = attn_body::cvtpk_s(f[4] * r * g[4], f[5] * r * g[5]); o.w = attn_body::cvtpk_s(f[6] * r * g[6], f[7] * r * g[7]);
          *(MLAS u32x4*)(L + K_OFF + (p * 32 + r0) * KSTR + c * 16) = o; } }
    { const int c = tid & 31, r0 = tid >> 5;
      typedef unsigned u32x2_t __attribute__((ext_vector_type(2)));
      const unsigned short* src = VT + ((long)hm * 128 + r0) * 4096 + b * 256 + c * 8;
#pragma unroll
      for (int p = 0; p < 8; ++p) { const u32x4 v = *reinterpret_cast<const u32x4*>(src + (long)p * 16 * 4096); MLAS unsigned char* d = L + V_OFF + (p * 16 + r0) * VSTR + c * 16;
          *(MLAS u32x2_t*)d = (u32x2_t){v.x, v.y}; *(MLAS u32x2_t*)(d + 8) = (u32x2_t){v.z, v.w}; } }
}
__device__ __forceinline__ void unit(int b, int hm, int qb, const unsigned short* QM, unsigned short* OM, MLAS unsigned char* L) {
    int tid = threadIdx.x; asm volatile("" : "+v"(tid)); const int lane = tid & 63, r32 = lane & 31, hi = lane >> 5; const int wid = __builtin_amdgcn_readfirstlane(tid >> 6);
    MLAS float* wsf = (MLAS float*)(L + WSF_OFF + wid * 256);
    const long row0 = (long)b * 2048 + qb * 256 + wid * 32;
    const unsigned short* Qw = QM + (row0 + r32) * 512 + hm * 128 + hi * 8;
    bf16x8 qr[8];
#pragma unroll
    for (int d0 = 0; d0 < 8; ++d0) qr[d0] = *reinterpret_cast<const bf16x8*>(Qw + d0 * 16);
    const MLAS unsigned char* Kb = L + K_OFF + r32 * KSTR + hi * 16;
    f32x16 s[8];
#pragma unroll
    for (int kb = 0; kb < 8; ++kb) { f32x16 a = f32x16{};
#pragma unroll
        for (int d0 = 0; d0 < 8; ++d0) { const bf16x8 kf = *(const MLAS bf16x8*)(Kb + kb * 32 * KSTR + d0 * 32); a = __builtin_amdgcn_mfma_f32_32x32x16_bf16(kf, qr[d0], a, 0, 0, 0); }
        s[kb] = a; }
    float mx = s[0][0];
#pragma unroll
    for (int kb = 0; kb < 8; ++kb)
#pragma unroll
        for (int r = 0; r < 16; ++r) mx = fmaxf(mx, s[kb][r]);
    mx = fmaxf(mx, __shfl_xor(mx, 32));
    float l = 0.f;
#pragma unroll
    for (int kb = 0; kb < 8; ++kb)
#pragma unroll
        for (int r = 0; r < 16; ++r) { const float e = __builtin_amdgcn_exp2f(s[kb][r] - mx); s[kb][r] = e; l += e; }
    l += __shfl_xor(l, 32);
    if (hi == 0) wsf[r32] = l;
    const MLAS unsigned char* Vb = L + V_OFF + r32 * VSTR + hi * 8;
    f32x16 o[4]; o[0] = f32x16{}; o[1] = f32x16{}; o[2] = f32x16{}; o[3] = f32x16{};
#pragma unroll
    for (int ks = 0; ks < 16; ++ks) { const int kb = ks >> 1, h8 = (ks & 1) * 8;
        u32x4 pw; pw.x = attn_body::cvtpk_s(s[kb][h8 + 0], s[kb][h8 + 1]); pw.y = attn_body::cvtpk_s(s[kb][h8 + 2], s[kb][h8 + 3]); pw.z = attn_body::cvtpk_s(s[kb][h8 + 4], s[kb][h8 + 5]); pw.w = attn_body::cvtpk_s(s[kb][h8 + 6], s[kb][h8 + 7]);
        const bf16x8 pa = __builtin_bit_cast(bf16x8, pw);
#pragma unroll
        for (int db = 0; db < 4; ++db) { const MLAS unsigned char* vp = Vb + db * 32 * VSTR + ks * 32;
            const s16x4 lo = *(const MLAS s16x4*)vp, h4 = *(const MLAS s16x4*)(vp + 16);
            const bf16x8 vf = (bf16x8){lo[0], lo[1], lo[2], lo[3], h4[0], h4[1], h4[2], h4[3]};
            o[db] = __builtin_amdgcn_mfma_f32_32x32x16_bf16(pa, vf, o[db], 0, 0, 0); } }
    asm volatile("s_waitcnt lgkmcnt(0)" ::: "memory");
    unsigned short* Ow = OM + row0 * 2048 + hm * 128 + r32;
#pragma unroll
    for (int r = 0; r < 16; ++r) { const int q = attn_body::crow(r, hi); const float rl = __builtin_amdgcn_rcpf(wsf[q]);
#pragma unroll
        for (int db = 0; db < 4; ++db) { const unsigned w = attn_body::cvtpk_s(o[db][r] * rl, 0.f); Ow[(long)q * 2048 + db * 32] = (unsigned short)(w & 0xffffu); } }
    asm volatile("s_waitcnt lgkmcnt(0)" ::: "memory");
}
#undef MLAS
}

constexpr int NWAVES = 8;
#ifndef MK_N_LAUNCHES
#define MK_N_LAUNCHES 1
#endif
constexpr int NPH = 12;
#ifndef PROBE_DOUBLE_MASK
#define PROBE_DOUBLE_MASK 0
#endif
constexpr int B_ = 16, S_ = 2048, DM_ = 2048, M_ = B_ * S_, FF_ = 5632, MEML = 256, MM_ = B_ * MEML;
constexpr int NWIN = 10496, NWIN_SRC = 10256;
constexpr float EPS_ = 1e-6f, LOG2E = 1.4426950408889634f;
constexpr size_t MiB = 1u << 20;
constexpr size_t WS_GU = 1 * MiB, WS_DN = 45 * MiB, WS_WIN = 67 * MiB, WS_WMKV = 108 * MiB, WS_WCAT = 112 * MiB, WS_WO = 120 * MiB;
constexpr size_t WS_H = 128 * MiB;
constexpr size_t WS_MEMN = 256 * MiB, WS_KM = 272 * MiB, WS_VT = 276 * MiB, WS_LOGF = 280 * MiB, WS_CL = 282 * MiB;
constexpr size_t WS_BIG = 284 * MiB;
constexpr size_t WS_UP = WS_BIG, WS_PD = WS_BIG + 32 * MiB, WS_QF = WS_BIG + 64 * MiB, WS_KF = WS_BIG + 128 * MiB, WS_VF = WS_BIG + 192 * MiB, WS_QM = WS_BIG + 256 * MiB, WS_GATE = WS_BIG + 288 * MiB;
constexpr size_t WS_END = WS_GATE + 384 * MiB;
constexpr size_t WS_BAR = 512 * 1024, WS_BAR_BYTES = 16384;
constexpr size_t WS_SSQ1 = 0, WS_SSQ2 = 256 * 1024;
constexpr size_t WS_H3 = WS_BIG + 352 * MiB;
static_assert(WS_BIG + (size_t)M_ * FF_ * 2 <= WS_END && WS_WO + 8 * MiB <= WS_H && WS_WIN + (size_t)NWIN * DM_ * 2 <= WS_WMKV, "d_ws map");
constexpr int RING_BYTES = 131072, LDS_BYTES = 147456;
static_assert(attn_body::ATTN_LDS_BYTES <= RING_BYTES && memattn::MEM_LDS_BYTES <= LDS_BYTES, "attention scratch fits");

#define GAS __attribute__((address_space(1)))
#define LAS __attribute__((address_space(3)))
typedef unsigned short bf16;
typedef unsigned v4u __attribute__((ext_vector_type(4)));
typedef unsigned v2u __attribute__((ext_vector_type(2)));
typedef float f32x4 __attribute__((ext_vector_type(4)));
#define LDS_WAIT() asm volatile("s_waitcnt lgkmcnt(0)" ::: "memory")
__device__ __forceinline__ unsigned f2bf(float f) { unsigned u = __builtin_bit_cast(unsigned, f); return (u + 0x7fffu + ((u >> 16) & 1u)) >> 16; }
__device__ __forceinline__ unsigned pk2(float lo, float hi) { return f2bf(lo) | (f2bf(hi) << 16); }
__device__ __forceinline__ float wave_sum(float v) {
#pragma unroll
    for (int o = 1; o < 64; o <<= 1) v += __shfl_xor(v, o);
    return v;
}
__device__ __forceinline__ int dmap(int map, int n) {
    if (map == 1) { const int up = n >= FF_ ? 1 : 0; const int c = up ? n - FF_ : n; return (c >> 7) * 256 + up * 128 + (c & 127); }
    if (map == 2) { return n < 3584 ? n : (n < 3600 ? 10240 + (n - 3584) : n - 16); }
    return n;
}
__device__ __forceinline__ float colscale(int map, int n) {
    if (map == 1) return n < FF_ ? LOG2E : (1.0f / LOG2E);
    if (map == 2) return n >= 4112 ? LOG2E : 1.0f;
    return 1.0f;
}
constexpr int TSCR = 64 * 65 * 4;
__device__ __forceinline__ void transpose_item(const float* W, int K, int N, bf16* WT, int map, LAS float* scr, int item, int lane, int ldk = 0, int koff = 0, const float* kgain = nullptr) {
    if (ldk == 0) ldk = K;
    const int nblk = (N + 63) / 64, kb = item / nblk, nb = item % nblk, k0 = 64 * kb, n0 = 64 * nb;
    const int kq = lane >> 4, c = lane & 15, nc = n0 + 4 * c; const bool okc = nc < N;
    f32x4 v[16];
    const float* src = W + (size_t)(k0 + kq) * N + nc;
#pragma unroll
    for (int i = 0; i < 16; ++i) v[i] = okc ? *(const f32x4*)(src + (size_t)(4 * i) * N) : (f32x4){0.f, 0.f, 0.f, 0.f};
#pragma unroll
    for (int i = 0; i < 16; ++i) { LAS float* d = scr + (4 * i + kq) * 65 + 4 * c; const float kg = kgain ? kgain[k0 + 4 * i + kq] : 1.0f;
        d[0] = v[i].x * kg; d[1] = v[i].y * kg; d[2] = v[i].z * kg; d[3] = v[i].w * kg; }
    LDS_WAIT(); asm volatile("" ::: "memory");
    const int cc = lane & 7, nn = lane >> 3;
#pragma unroll
    for (int j = 0; j < 8; ++j) { const int n = nn + 8 * j; const LAS float* s = scr + (8 * cc) * 65 + n; const float cs = colscale(map, n0 + n);
        v4u o; o.x = pk2(s[0 * 65] * cs, s[1 * 65] * cs); o.y = pk2(s[2 * 65] * cs, s[3 * 65] * cs); o.z = pk2(s[4 * 65] * cs, s[5 * 65] * cs); o.w = pk2(s[6 * 65] * cs, s[7 * 65] * cs);
        if (n0 + n < N) *(v4u*)(WT + (size_t)dmap(map, n0 + n) * ldk + koff + k0 + 8 * cc) = o; }
    LDS_WAIT(); asm volatile("" ::: "memory");
}
__device__ __forceinline__ int transpose_items(int K, int N) { return (K / 64) * ((N + 63) / 64); }
__device__ __forceinline__ void norm_row(const float* xrow, const float* gain, bf16* orow, int lane) {
    const f32x4* xr = (const f32x4*)xrow + lane; const f32x4* gr = (const f32x4*)gain + lane;
    f32x4 v[8]; float s = 0.f;
#pragma unroll
    for (int j = 0; j < 8; ++j) { v[j] = xr[64 * j]; s += (v[j].x * v[j].x + v[j].y * v[j].y) + (v[j].z * v[j].z + v[j].w * v[j].w); }
    const float r = 1.0f / sqrtf(wave_sum(s) * (1.0f / 2048.0f) + EPS_);
    v2u* o8 = (v2u*)orow + lane;
#pragma unroll
    for (int j = 0; j < 8; ++j) { const f32x4 g = gr[64 * j]; v2u w; w.x = pk2(v[j].x * r * g.x, v[j].y * r * g.y); w.y = pk2(v[j].z * r * g.z, v[j].w * r * g.w); o8[64 * j] = w; }
}
__device__ __forceinline__ void headnorm(bf16* X, int rows, int W, int HD, const float* gain, float scale, int gtid, int NT) {
    const int cpr = W / 8; const long total = (long)rows * cpr;
    for (long base = gtid; base < total; base += 4l * NT) {
        v4u v[4];
#pragma unroll
        for (int k = 0; k < 4; ++k) { const long idx = base + (long)k * NT; if (idx < total) v[k] = *(const v4u*)(X + idx * 8); }
#pragma unroll
        for (int k = 0; k < 4; ++k) { const long idx = base + (long)k * NT; if (idx < total) { const int ch = (int)(idx % cpr);
            float f[8] = {pg8::bf_lo(v[k].x), pg8::bf_hi(v[k].x), pg8::bf_lo(v[k].y), pg8::bf_hi(v[k].y), pg8::bf_lo(v[k].z), pg8::bf_hi(v[k].z), pg8::bf_lo(v[k].w), pg8::bf_hi(v[k].w)};
            float ss = 0.f;
#pragma unroll
            for (int j = 0; j < 8; ++j) ss += f[j] * f[j];
            ss += __shfl_xor(ss, 1); ss += __shfl_xor(ss, 2); ss += __shfl_xor(ss, 4); if (HD == 128) ss += __shfl_xor(ss, 8);
            const float r = scale / sqrtf(ss / (float)HD + EPS_);
            const float* g = gain + ((ch * 8) % HD);
            v4u o; o.x = pk2(f[0] * r * g[0], f[1] * r * g[1]); o.y = pk2(f[2] * r * g[2], f[3] * r * g[3]); o.z = pk2(f[4] * r * g[4], f[5] * r * g[5]); o.w = pk2(f[6] * r * g[6], f[7] * r * g[7]);
            *(v4u*)(X + idx * 8) = o; } } }
}

#define XB_TMO      128
#define XB_XCNT(j)  (256  + 64 * (j))
#define XB_XSUB(j)  (1280 + 64 * (j))
#define XB_XGEN(j)  (2304 + 64 * (j))
#define XB_TOP      3328
#define XB_TOPGEN   3392
#define XCD_BAR_WORDS 3456
#define XB_SPIN_CAP (1u << 18)

__device__ __forceinline__ unsigned xb_ld(unsigned* p)              { return __hip_atomic_load(p, __ATOMIC_RELAXED, __HIP_MEMORY_SCOPE_AGENT); }
__device__ __forceinline__ unsigned xb_add(unsigned* p, unsigned v) { return __hip_atomic_fetch_add(p, v, __ATOMIC_RELAXED, __HIP_MEMORY_SCOPE_AGENT); }
__device__ __forceinline__ unsigned xb_xcc_id() { return (unsigned)__builtin_amdgcn_s_getreg((3 << 11) | 20) & 0xFu; }
#define XB_SPIN(cond, bar) do { unsigned _sp = 0; while (cond) { __builtin_amdgcn_s_sleep(1); \
    if ((++_sp & 255u) == 0u) { if (xb_ld(&(bar)[XB_TMO])) break; if (_sp > XB_SPIN_CAP) { atomicAdd(&(bar)[XB_TMO], 1u); break; } } } } while (0)

struct XcdBarrier {
    unsigned* bar; unsigned x;
    volatile LAS unsigned* st;
};

__device__ __forceinline__ XcdBarrier xcd_barrier_post(unsigned* bar, volatile LAS unsigned* st) {
    XcdBarrier b; b.bar = bar; b.x = xb_xcc_id(); b.st = st;
    if (threadIdx.x == 0) (void)xb_add(&bar[XB_XCNT(b.x)], 1u);
    return b;
}
__device__ __forceinline__ void xcd_barrier_complete(unsigned* bar, unsigned x, unsigned& nloc, unsigned& nx) {
    const unsigned G = gridDim.x * gridDim.y * gridDim.z;
    unsigned sum, cnt, mine, sp = 0u;
    for (;;) {
        sum = 0u; cnt = 0u; mine = 0u;
#pragma unroll
        for (unsigned j = 0; j < 16; ++j) { const unsigned c = xb_ld(&bar[XB_XCNT(j)]); sum += c; cnt += (c > 0u) ? 1u : 0u; mine = (j == x) ? c : mine; }
        if (sum == G) break;
        __builtin_amdgcn_s_sleep(1);
        if ((++sp & 255u) == 0u) { if (xb_ld(&bar[XB_TMO])) break; if (sp > XB_SPIN_CAP) { atomicAdd(&bar[XB_TMO], 1u); break; } }
    }
    nloc = mine > 0u ? mine : 1u; nx = cnt > 0u ? cnt : 1u;
}

__device__ __forceinline__ void xcd_barrier(const XcdBarrier& b) {
    asm volatile("s_waitcnt vmcnt(0)" ::: "memory");
    __syncthreads();
    if (threadIdx.x == 0) {
        unsigned* bar = b.bar;
        __builtin_amdgcn_s_waitcnt(0);
        unsigned nloc = b.st[0], nx = b.st[1];
        if (nloc == 0u) { xcd_barrier_complete(bar, b.x, nloc, nx); b.st[0] = nloc; b.st[1] = nx; }
        const unsigned old = xb_add(&bar[XB_XSUB(b.x)], 1u);
        const unsigned gen = old / nloc;
        if (old + 1u == (gen + 1u) * nloc) {
            __builtin_amdgcn_fence(__ATOMIC_RELEASE, "agent");
            asm volatile("s_waitcnt vmcnt(0)" ::: "memory");
            const unsigned og = xb_add(&bar[XB_TOP], 1u);
            const unsigned tg = og / nx;
            if (og + 1u == (tg + 1u) * nx) xb_add(&bar[XB_TOPGEN], 1u);
            else XB_SPIN(xb_ld(&bar[XB_TOPGEN]) == tg, bar);
            __builtin_amdgcn_fence(__ATOMIC_ACQUIRE, "agent");
            xb_add(&bar[XB_XGEN(b.x)], 1u);
            asm volatile("s_waitcnt vmcnt(0)" ::: "memory");
        } else {
            XB_SPIN(xb_ld(&bar[XB_XGEN(b.x)]) == gen, bar);
            __builtin_amdgcn_fence(__ATOMIC_ACQUIRE, "agent");
            asm volatile("s_waitcnt vmcnt(0)" ::: "memory");
        }
    }
    __syncthreads();
}

struct Args { const float* in[23]; float* out; unsigned char* ws; int ph_lo, ph_hi; };

__global__ void __launch_bounds__(NWAVES * 64, 2) mk_fwd(Args args) {
    __builtin_assume(__builtin_amdgcn_workitem_id_y() == 0); __builtin_assume(__builtin_amdgcn_workitem_id_z() == 0);
    extern __shared__ __attribute__((aligned(16))) unsigned char lds[];
    LAS unsigned char* L = (LAS unsigned char*)lds;
    const int tid = threadIdx.x, lane = tid & 63, wave = __builtin_amdgcn_readfirstlane(tid >> 6);
    const int G = gridDim.x, bx = blockIdx.x, vcu = (G % 8 == 0) ? (bx % 8) * (G / 8) + bx / 8 : bx;
    const int gw = vcu * NWAVES + wave, NGW = G * NWAVES, gtid = gw * 64 + lane, NT = NGW * 64;
    unsigned char* ws = args.ws;
    if (tid < 16) ((LAS unsigned*)(L + LDS_BYTES - 64))[tid] = 0u;
    __syncthreads();
    const XcdBarrier gbar = xcd_barrier_post((unsigned*)(ws + WS_BAR), (volatile LAS unsigned*)(L + LDS_BYTES - 64));
    LAS float* scr = (LAS float*)(L + wave * TSCR);

    const int lo = args.ph_lo, hi = args.ph_hi;
#define IN(k) (lo <= (k) && (k) < hi)
#define SEAM(k) do { if ((k) + 1 < hi) { xcd_barrier(gbar); } } while (0)
#define GEMM(EPI, g, E, crot) do { pg8::StaticOrder S_; S_.init((g).M, (g).N, G, (bx + (crot)) % G); pg8::gemm_phase<EPI, pg8::StaticOrder, true, true>(L, g, S_, E); } while (0)

    if (IN(0)) {
        const int i0 = transpose_items(2048, 11264), i1 = transpose_items(5632, 2048), i2 = transpose_items(2048, NWIN_SRC), i3 = transpose_items(1024, 2048), i4 = transpose_items(2048, 1024),
                  i5 = transpose_items(512, 2048), i6 = transpose_items(2048, 2048);
        const int total = i0 + i1 + i2 + i3 + i4 + i5 + i6;
        for (int it = gw; it < total; it += NGW) { int r = it;
            if (r < i0) { transpose_item(args.in[3], 2048, 11264, (bf16*)(ws + WS_GU), 1, scr, r, lane); continue; } r -= i0;
            if (r < i1) { transpose_item(args.in[4], 5632, 2048, (bf16*)(ws + WS_DN), 0, scr, r, lane); continue; } r -= i1;
            if (r < i2) { transpose_item(args.in[7], 2048, NWIN_SRC, (bf16*)(ws + WS_WIN), 2, scr, r, lane, 0, 0, args.in[5]); continue; } r -= i2;
            if (r < i3) { transpose_item(args.in[14], 1024, 2048, (bf16*)(ws + WS_WCAT), 0, scr, r, lane, 2048, 512); continue; } r -= i3;
            if (r < i4) { transpose_item(args.in[15], 2048, 1024, (bf16*)(ws + WS_WMKV), 0, scr, r, lane); continue; } r -= i4;
            if (r < i5) { transpose_item(args.in[18], 512, 2048, (bf16*)(ws + WS_WCAT), 0, scr, r, lane, 2048, 1536); continue; } r -= i5;
            transpose_item(args.in[19], 2048, 2048, (bf16*)(ws + WS_WO), 0, scr, r, lane); }
        for (int i = gtid; i < 2 * M_; i += NT) { ((float*)(ws + WS_SSQ1))[i < M_ ? i : i - M_ + (int)((WS_SSQ2 - WS_SSQ1) / 4)] = 0.f; }
        for (int i = gtid; i < 240 * 256; i += NT) *(v4u*)(ws + WS_WIN + (size_t)10256 * 4096 + (size_t)i * 16) = (v4u){0u, 0u, 0u, 0u};
        { const float* pw = args.in[9]; const float* ps = args.in[10]; const float* wpu = args.in[11]; bf16* WP = (bf16*)(ws + WS_WCAT);
          for (int it = gw; it < 2048; it += NGW) { const int nb = it >> 6, cc = it & 63, g = cc >> 4, c0 = (cc & 15) * 8, n = nb * 64 + lane;
            float a0 = 0.f, a1 = 0.f, a2 = 0.f, a3 = 0.f, a4 = 0.f, a5 = 0.f, a6 = 0.f, a7 = 0.f;
            const float* pr = pw + (size_t)(g * 128 + c0) * 128;
#pragma unroll 16
            for (int d = 0; d < 128; ++d) { const float wv = ps[g * 128 + d] * wpu[(size_t)(g * 128 + d) * 2048 + n];
                a0 += pr[d] * wv; a1 += pr[128 + d] * wv; a2 += pr[256 + d] * wv; a3 += pr[384 + d] * wv; a4 += pr[512 + d] * wv; a5 += pr[640 + d] * wv; a6 += pr[768 + d] * wv; a7 += pr[896 + d] * wv; }
            v4u o; o.x = pk2(a0, a1); o.y = pk2(a2, a3); o.z = pk2(a4, a5); o.w = pk2(a6, a7);
            *(v4u*)(WP + (size_t)n * 2048 + cc * 8) = o; } }
        for (int m = gw; m < M_; m += NGW) norm_row(args.in[0] + (size_t)m * 2048, args.in[2], (bf16*)(ws + WS_H) + (size_t)m * 2048, lane);
        for (int m = gw; m < MM_; m += NGW) norm_row(args.in[1] + (size_t)m * 2048, args.in[6], (bf16*)(ws + WS_MEMN) + (size_t)m * 2048, lane);
        SEAM(0);
    }
    if (IN(1)) {
        __syncthreads();
        { const pg8::Gemm g{(const bf16*)(ws + WS_H), (const bf16*)(ws + WS_GU), M_, 2 * FF_, 2048}; const pg8::EpiSwiGLU E{(bf16*)(ws + WS_BIG), FF_, nullptr}; GEMM(pg8::EpiSwiGLU, g, E, 0); }
        SEAM(1);
    }
    if (IN(2)) {
        __syncthreads();
        { const pg8::Gemm g{(const bf16*)(ws + WS_BIG), (const bf16*)(ws + WS_DN), M_, 2048, FF_}; const pg8::EpiResid E{args.in[0], nullptr, nullptr, (bf16*)(ws + WS_H), (float*)(ws + WS_SSQ1), 2048, 0.5f}; GEMM(pg8::EpiResid, g, E, 0); }
        SEAM(2);
    }
    if (IN(4)) {
        __syncthreads();
        { const pg8::Gemm g{(const bf16*)(ws + WS_H), (const bf16*)(ws + WS_WIN), M_, NWIN, 2048};
          const pg8::EpiWin E{(bf16*)(ws + WS_UP), (bf16*)(ws + WS_QF), (bf16*)(ws + WS_KF), (bf16*)(ws + WS_VF), (bf16*)(ws + WS_QM), (bf16*)(ws + WS_GATE), (float*)(ws + WS_LOGF), args.in[8], (const float*)(ws + WS_SSQ1), args.in[12], args.in[13], args.in[16], (LAS float*)(L + RING_BYTES)};
          GEMM(pg8::EpiWin, g, E, 0); }
        { const pg8::Gemm g{(const bf16*)(ws + WS_MEMN), (const bf16*)(ws + WS_WMKV), MM_, 512, 2048}; const pg8::EpiBf16<0> E{(bf16*)(ws + WS_KM), 512, nullptr, 0, 0, 1.f}; GEMM(pg8::EpiBf16<0>, g, E, G / 2); }
        { const pg8::Gemm g{(const bf16*)(ws + WS_WMKV) + (size_t)512 * 2048, (const bf16*)(ws + WS_MEMN), 512, MM_, 2048}; const pg8::EpiBf16<0> E{(bf16*)(ws + WS_VT), MM_, nullptr, 0, 0, 1.f}; GEMM(pg8::EpiBf16<0>, g, E, (3 * G) / 8); }
        if (bx >= (3 * G) / 4) { const int gw2 = (bx - (3 * G) / 4) * NWAVES + wave, NGW2 = (G - (3 * G) / 4) * NWAVES;
          const int i0 = transpose_items(2048, 11264), i1 = transpose_items(5632, 2048);
          for (int it = gw2; it < i0 + i1; it += NGW2) {
            if (it < i0) transpose_item(args.in[21], 2048, 11264, (bf16*)(ws + WS_GU), 1, scr, it, lane, 0, 0, args.in[20]);
            else transpose_item(args.in[22], 5632, 2048, (bf16*)(ws + WS_DN), 0, scr, it - i0, lane); } }
        SEAM(4);
    }
    if (IN(6)) {
        { const bf16* UP = (const bf16*)(ws + WS_UP); bf16* PD = (bf16*)args.out;
          for (int it = gtid; it < (M_ / 8) * 64; it += NT) { const int cc = it & 63, m0 = (it >> 6) * 8, t0 = m0 & (S_ - 1), w = 2 << (cc >> 4);
            const bf16* up = UP + (size_t)m0 * 512 + cc * 8;
            v4u hv[15], cv[8];
#pragma unroll
            for (int j = 0; j < 15; ++j) { hv[j] = (v4u){0u, 0u, 0u, 0u}; if (j + 1 < w && t0 >= j + 1) hv[j] = *(const v4u*)(up - (size_t)(j + 1) * 512); }
#pragma unroll
            for (int r = 0; r < 8; ++r) cv[r] = *(const v4u*)(up + (size_t)r * 512);
#pragma unroll
            for (int r = 0; r < 8; ++r) { float s0 = 0.f, s1 = 0.f, s2 = 0.f, s3 = 0.f, s4 = 0.f, s5 = 0.f, s6 = 0.f, s7 = 0.f;
#pragma unroll
                for (int j = 0; j < 16; ++j) { if (j <= r + 15) { const v4u v = (r - j >= 0) ? cv[(r - j >= 0) ? r - j : 0] : hv[(j - r - 1 >= 0 && j - r - 1 < 15) ? j - r - 1 : 0];
                    if (j < w) { s0 += pg8::bf_lo(v.x); s1 += pg8::bf_hi(v.x); s2 += pg8::bf_lo(v.y); s3 += pg8::bf_hi(v.y); s4 += pg8::bf_lo(v.z); s5 += pg8::bf_hi(v.z); s6 += pg8::bf_lo(v.w); s7 += pg8::bf_hi(v.w); } } }
                const int tt = t0 + r + 1; const float rn = 1.0f / (float)(tt < w ? tt : w); const v4u c = cv[r];
                v4u o; o.x = pk2(s0 * rn - pg8::bf_lo(c.x), s1 * rn - pg8::bf_hi(c.x)); o.y = pk2(s2 * rn - pg8::bf_lo(c.y), s3 * rn - pg8::bf_hi(c.y));
                o.z = pk2(s4 * rn - pg8::bf_lo(c.z), s5 * rn - pg8::bf_hi(c.z)); o.w = pk2(s6 * rn - pg8::bf_lo(c.w), s7 * rn - pg8::bf_hi(c.w));
                *(v4u*)(PD + (size_t)(m0 + r) * 2048 + cc * 8) = o; } } }
        __syncthreads();
        { const attn_body::AttnTensors AT{(const attn_body::bf16*)(ws + WS_QF), (const attn_body::bf16*)(ws + WS_KF), (const attn_body::bf16*)(ws + WS_VF), (attn_body::bf16*)args.out + 512, (const float*)(ws + WS_LOGF)};
          const attn_body::StaticOrder S(G, vcu);
          attn_body::attn_phase<attn_body::StaticOrder, 40>((char*)lds, AT, S); }
        __syncthreads();
        for (int p = vcu; p < B_ * 4 * 4; p += G) { const int b = p >> 4, hm = (p >> 2) & 3;
            memattn::stage_kv(b, hm, (const bf16*)(ws + WS_KM), (const bf16*)(ws + WS_VT), args.in[17], L);
            __syncthreads();
            memattn::unit(b, hm, (p & 3) * 2, (const bf16*)(ws + WS_QM), (bf16*)args.out + 1536, L);
            memattn::unit(b, hm, (p & 3) * 2 + 1, (const bf16*)(ws + WS_QM), (bf16*)args.out + 1536, L);
            __syncthreads(); }
        SEAM(6);
    }
    if (IN(7)) {
        __syncthreads();
        { const pg8::Gemm g{(const bf16*)args.out, (const bf16*)(ws + WS_WCAT), M_, 2048, 2048}; const pg8::EpiGate E{(bf16*)(ws + WS_QF), (const bf16*)(ws + WS_GATE)}; GEMM(pg8::EpiGate, g, E, 0); }
        SEAM(7);
    }
    if (IN(8)) {
        __syncthreads();
        { const pg8::Gemm g{(const bf16*)(ws + WS_QF), (const bf16*)(ws + WS_WO), M_, 2048, 2048}; const pg8::EpiResid E{nullptr, (const bf16*)(ws + WS_H), nullptr, (bf16*)(ws + WS_H3), (float*)(ws + WS_SSQ2), 2048, 1.0f}; GEMM(pg8::EpiResid, g, E, 0); }
        SEAM(8);
    }
    if (IN(10)) {
        __syncthreads();
        { const pg8::Gemm g{(const bf16*)(ws + WS_H3), (const bf16*)(ws + WS_GU), M_, 2 * FF_, 2048}; const pg8::EpiSwiGLU E{(bf16*)(ws + WS_BIG), FF_, (const float*)(ws + WS_SSQ2)}; GEMM(pg8::EpiSwiGLU, g, E, 0); }
        SEAM(10);
    }
    if (IN(11)) {
        __syncthreads();
        { const pg8::Gemm g{(const bf16*)(ws + WS_BIG), (const bf16*)(ws + WS_DN), M_, 2048, FF_}; const pg8::EpiResid E{nullptr, (const bf16*)(ws + WS_H3), args.out, nullptr, nullptr, 2048, 0.5f}; GEMM(pg8::EpiResid, g, E, 0); }
    }
    if (hi > 4096) cg::this_grid().sync();
#undef IN
#undef SEAM
#undef GEMM
}

extern "C" void kernel_launch(void* const* d_in, const int* in_sizes, int n_in, void* d_out, int out_size, void* d_ws, size_t ws_size, hipStream_t stream) {
    static int grid = 0;
    if (grid == 0) {
        if (n_in != 23 || in_sizes[0] != M_ * DM_ || out_size != M_ * DM_ || ws_size < WS_END) { fprintf(stderr, "kernel_launch: unexpected problem (n_in %d, ws %zu < %zu?); nothing launched\n", n_in, ws_size, (size_t)WS_END); grid = -1; return; }
        int dev = 0, cus = 0, per_cu = 0;
        if (hipGetDevice(&dev) != hipSuccess || hipDeviceGetAttribute(&cus, hipDeviceAttributeMultiprocessorCount, dev) != hipSuccess) { grid = -1; return; }
        if (hipFuncSetAttribute((const void*)mk_fwd, hipFuncAttributeMaxDynamicSharedMemorySize, LDS_BYTES) != hipSuccess) { fprintf(stderr, "kernel_launch: hipFuncSetAttribute failed\n"); grid = -1; return; }
        if (hipOccupancyMaxActiveBlocksPerMultiprocessor(&per_cu, (const void*)mk_fwd, NWAVES * 64, LDS_BYTES) != hipSuccess || per_cu < 1) { fprintf(stderr, "kernel_launch: occupancy query says %d\n", per_cu); per_cu = 1; }
        (void)hipGetLastError();
        grid = cus * per_cu;
    }
    if (grid < 0) return;
    (void)hipMemsetAsync((unsigned char*)d_ws + WS_BAR, 0, WS_BAR_BYTES, stream);
    Args a{};
    for (int i = 0; i < 23; ++i) a.in[i] = (const float*)d_in[i];
    a.out = (float*)d_out; a.ws = (unsigned char*)d_ws;
#if MK_N_LAUNCHES == 1
    a.ph_lo = 0; a.ph_hi = NPH;
    void* kargs[] = {&a};
    hipError_t e = hipLaunchCooperativeKernel((const void*)mk_fwd, dim3(grid), dim3(NWAVES * 64), kargs, LDS_BYTES, stream);
    if (e != hipSuccess) fprintf(stderr, "kernel_launch: cooperative launch failed: %s (grid %d)\n", hipGetErrorString(e), grid);
#elif MK_N_LAUNCHES == 112
    for (int ph = 0; ph < NPH; ++ph) { a.ph_lo = ph; a.ph_hi = ph + 1; void* kargs[] = {&a}; (void)hipLaunchCooperativeKernel((const void*)mk_fwd, dim3(grid), dim3(NWAVES * 64), kargs, LDS_BYTES, stream); }
#else
    for (int ph = 0; ph < NPH; ++ph) { a.ph_lo = ph; a.ph_hi = ph + 1; for (int rep = 0; rep < (((PROBE_DOUBLE_MASK) >> ph) & 1) + 1; ++rep) hipLaunchKernelGGL(mk_fwd, dim3(grid), dim3(NWAVES * 64), LDS_BYTES, stream, a); }
#endif
}
```
